# Optimizing an MI355X kernel written in HIP

```python
import jax, jax.numpy as jnp
from jax import lax
import numpy as np

D_MODEL = 2048
BATCH = 4
SEQ = 2048
DEPTH = 1

GMLP_GROUPS = 8
GMLP_GROUP_DIM = 128
GMLP_WIDTH = GMLP_GROUPS * GMLP_GROUP_DIM
GMLP_CHUNK = 128
HG_HEADS = 8
HG_DK = 128
HG_DV = 128
HG_WIDTH = HG_HEADS * HG_DK
HG_CHUNK = 64
FFN_HIDDEN = -(-8 * D_MODEL // (3 * 256)) * 256
IN_WIDTH = 2 * GMLP_WIDTH + 4 * HG_WIDTH + 2 * D_MODEL
EPS = 1e-6

kernel_name = "hybrid_gmlp_hgrn2_adaln_block"


def rmsnorm(x, g):
    xf = x.astype(jnp.float32)
    y = xf * lax.rsqrt(jnp.mean(xf * xf, axis=-1, keepdims=True) + EPS)
    return (y * g.astype(jnp.float32)).astype(x.dtype)


def layernorm(x, g, b):
    xf = x.astype(jnp.float32)
    mu = jnp.mean(xf, axis=-1, keepdims=True)
    var = jnp.mean(jnp.square(xf - mu), axis=-1, keepdims=True)
    y = (xf - mu) * lax.rsqrt(var + EPS)
    return (y * g.astype(jnp.float32) + b.astype(jnp.float32)).astype(x.dtype)


def modulate(h, shift, scale):
    return h * (1 + scale[:, None, :]) + shift[:, None, :]


def gmlp_branch(u, v, ln_g, ln_b, ws, bs):
    B, S, _ = v.shape
    nc = S // GMLP_CHUNK
    v = layernorm(v, ln_g, ln_b)
    vc = v.reshape(B, nc, GMLP_CHUNK, GMLP_GROUPS, GMLP_GROUP_DIM)
    mask = jnp.tril(jnp.ones((GMLP_CHUNK, GMLP_CHUNK), dtype=bool))
    w = jnp.where(mask[None], ws, 0).astype(v.dtype)
    s = jnp.einsum('gts,bcsgd->bctgd', w, vc)
    s = s + jnp.transpose(bs)[None, None, :, :, None].astype(v.dtype)
    return u * s.reshape(B, S, GMLP_WIDTH)


def hgrn2_branch(q, f_pre, i, g, lb, norm_g):
    B, S, _ = q.shape
    dt = q.dtype
    f = lb + (1.0 - lb) * jax.nn.sigmoid(f_pre.astype(jnp.float32))
    log_f = jnp.log(f)
    k = 1.0 - f
    qa = jax.nn.silu(q.astype(jnp.float32))
    nc = S // HG_CHUNK

    def heads(t, d):
        return t.reshape(B, nc, HG_CHUNK, HG_HEADS, d).transpose(1, 0, 3, 2, 4)

    qc, kc, lfc = heads(qa, HG_DK), heads(k, HG_DK), heads(log_f, HG_DK)
    ic = heads(i.astype(jnp.float32), HG_DV)
    mask = jnp.tril(jnp.ones((HG_CHUNK, HG_CHUNK), dtype=bool))

    def step(state, inp):
        qt, kt, it, lft = inp
        b = jnp.cumsum(lft, axis=2)
        o_inter = jnp.einsum('bhtk,bhkv->bhtv', qt * jnp.exp(b), state)
        rel = b[:, :, :, None, :] - b[:, :, None, :, :]
        decay = jnp.exp(jnp.where(mask[:, :, None], rel, -jnp.inf))
        attn = jnp.einsum('bhtk,bhsk,bhtsk->bhts', qt, kt, decay)
        o = o_inter + jnp.einsum('bhts,bhsv->bhtv', attn, it)
        b_last = b[:, :, -1:, :]
        new_state = jnp.exp(b_last[:, :, 0, :])[..., None] * state + jnp.einsum(
            'bhsk,bhsv->bhkv', kt * jnp.exp(b_last - b), it)
        return new_state, o

    s0 = jnp.zeros((B, HG_HEADS, HG_DK, HG_DV), jnp.float32)
    _, o = lax.scan(step, s0, (qc, kc, ic, lfc))
    o = o.transpose(1, 0, 3, 2, 4).reshape(B, S, HG_HEADS, HG_DV)
    o = o * lax.rsqrt(jnp.mean(o * o, axis=-1, keepdims=True) + EPS)
    o = o.reshape(B, S, HG_HEADS * HG_DV) * norm_g.astype(jnp.float32) * jax.nn.silu(g.astype(jnp.float32))
    return o.astype(dt)


def setup_inputs(seed: int = 0) -> dict:
    key = jax.random.key(seed)
    ks = jax.random.split(key, 24)
    f32 = jnp.float32
    nrm = lambda k, shape, s: jax.random.normal(k, shape, f32) * s
    L, D = DEPTH, D_MODEL
    return {
        "x": nrm(ks[0], (BATCH, SEQ, D), 1.0),
        "c": nrm(ks[1], (BATCH, D), 1.0),
        "w_ada": nrm(ks[2], (L, D, 6 * D), 0.5 * D ** -0.5),
        "b_ada": nrm(ks[3], (L, 6 * D), 0.02),
        "norm1_g": 1.0 + nrm(ks[4], (L, D), 0.02),
        "w_in": nrm(ks[5], (L, D, IN_WIDTH), D ** -0.5),
        "b_gate": nrm(ks[6], (L, 2 * D), 0.02),
        "gmlp_ln_g": 1.0 + nrm(ks[7], (L, GMLP_WIDTH), 0.02),
        "gmlp_ln_b": nrm(ks[8], (L, GMLP_WIDTH), 0.02),
        "gmlp_ws": nrm(ks[9], (L, GMLP_GROUPS, GMLP_CHUNK, GMLP_CHUNK), GMLP_CHUNK ** -0.5),
        "gmlp_bs": 1.0 + nrm(ks[10], (L, GMLP_GROUPS, GMLP_CHUNK), 0.1),
        "hg_lb": nrm(ks[11], (DEPTH + 1, HG_WIDTH), 1.0),
        "hg_norm_g": 1.0 + nrm(ks[12], (L, HG_WIDTH), 0.02),
        "w_branch_gmlp": nrm(ks[13], (L, GMLP_WIDTH, D), GMLP_WIDTH ** -0.5),
        "w_branch_hg": nrm(ks[14], (L, HG_WIDTH, D), HG_WIDTH ** -0.5),
        "w_out": nrm(ks[15], (L, D, D), D ** -0.5),
        "norm2_g": 1.0 + nrm(ks[16], (L, D), 0.02),
        "w_ffn_in": nrm(ks[17], (L, D, 2 * FFN_HIDDEN), D ** -0.5),
        "w_ffn_out": nrm(ks[18], (L, FFN_HIDDEN, D), FFN_HIDDEN ** -0.5),
        "final_norm_g": 1.0 + nrm(ks[19], (D,), 0.02),
    }


def reference(x, c, w_ada, b_ada, norm1_g, w_in, b_gate, gmlp_ln_g, gmlp_ln_b, gmlp_ws, gmlp_bs,
              hg_lb, hg_norm_g, w_branch_gmlp, w_branch_hg, w_out, norm2_g, w_ffn_in, w_ffn_out,
              final_norm_g):
    lb_all = jnp.cumsum(jax.nn.softmax(hg_lb.astype(jnp.float32), axis=0), axis=0)
    splits = np.cumsum([GMLP_WIDTH, GMLP_WIDTH, HG_WIDTH, HG_WIDTH, HG_WIDTH, HG_WIDTH, D_MODEL]).tolist()
    c_act = jax.nn.silu(c)
    for l in range(DEPTH):
        mod = c_act @ w_ada[l] + b_ada[l]
        sh1, sc1, gt1, sh2, sc2, gt2 = jnp.split(mod, 6, axis=-1)
        h = modulate(rmsnorm(x, norm1_g[l]), sh1, sc1)
        z = h @ w_in[l]
        u, v, q, f_pre, iv, og, ga, gb = jnp.split(z, splits, axis=-1)
        ya = gmlp_branch(jax.nn.gelu(u), jax.nn.gelu(v), gmlp_ln_g[l], gmlp_ln_b[l], gmlp_ws[l], gmlp_bs[l])
        yb = hgrn2_branch(q, f_pre, iv, og, lb_all[l], hg_norm_g[l])
        ga = jax.nn.sigmoid(ga + b_gate[l, :D_MODEL])
        gb = jax.nn.sigmoid(gb + b_gate[l, D_MODEL:])
        y = ga * (ya @ w_branch_gmlp[l]) + gb * (yb @ w_branch_hg[l])
        x = x + gt1[:, None, :] * (y @ w_out[l])
        h = modulate(rmsnorm(x, norm2_g[l]), sh2, sc2)
        a, up = jnp.split(h @ w_ffn_in[l], 2, axis=-1)
        x = x + gt2[:, None, :] * ((jax.nn.silu(a) * up) @ w_ffn_out[l])
    return rmsnorm(x, final_norm_g)
```

```cpp
#include <hip/hip_runtime.h>
#include <hip/hip_cooperative_groups.h>
#include <cstdio>
namespace cg = cooperative_groups;

#define LAS __attribute__((address_space(3)))
typedef unsigned short bf16_t;
typedef short bf16x8 __attribute__((ext_vector_type(8)));
typedef short s16x4 __attribute__((ext_vector_type(4)));
typedef float f32x4 __attribute__((ext_vector_type(4)));
typedef float f32x2 __attribute__((ext_vector_type(2)));
typedef unsigned u32x4 __attribute__((ext_vector_type(4)));
typedef unsigned u32x2 __attribute__((ext_vector_type(2)));

constexpr int DM = 2048, NB = 4, SEQ = 2048, NTOK = NB * SEQ, INW = 10240, FH = 5632;
constexpr int BM = 256, BK = 64, HALF = 128, HTB = HALF * BK * 2, STAGE_BYTES = 8 * HTB, NXCD = 8, WGM = 8;
constexpr int KSPLIT = 32;
constexpr int GEMV_CNT = 7744;
constexpr int TLB5_OFF = 117760, XST_OFF = TLB5_OFF + 128 * 65 * 4, DYN_LDS = XST_OFF + 16;
constexpr float EPSF = 1e-6f;

constexpr size_t al256(size_t b) { return (b + 255) & ~(size_t)255; }
constexpr size_t OFF_WAT = 0;
constexpr size_t OFF_WBT = OFF_WAT + al256((size_t)2048 * 1024 * 2);
constexpr size_t OFF_WOUT = OFF_WBT + al256((size_t)2048 * 1024 * 2);
constexpr size_t OFF_WFI = OFF_WOUT + al256((size_t)2048 * 2048 * 2);
constexpr size_t OFF_WFO = OFF_WFI + al256((size_t)2 * FH * 2048 * 2);
constexpr size_t OFF_R1 = OFF_WFO + al256((size_t)2048 * FH * 2);
constexpr size_t OFF_H = OFF_R1 + (size_t)INW * 2048 * 2;
constexpr size_t OFF_UV = OFF_R1 + al256((size_t)INW * 2048 * 2 + (size_t)NTOK * 2048 * 2);
constexpr size_t OFF_R2 = OFF_UV + al256((size_t)NTOK * 2048 * 2);
constexpr size_t OFF_LF = OFF_R2 + (size_t)NTOK * 3072 * 2;
constexpr size_t OFF_GAB = OFF_LF + (size_t)NTOK * 1024 * 4;
constexpr size_t OFF_YA = OFF_R2 + al256((size_t)NTOK * 3072 * 2 + (size_t)NTOK * 1024 * 4 + (size_t)NTOK * 4096 * 2);
constexpr size_t OFF_YB = OFF_YA + al256((size_t)NTOK * 1024 * 2);
constexpr size_t OFF_DV = OFF_YB + al256((size_t)NTOK * 1024 * 2);
constexpr size_t OFF_PART = OFF_DV + al256((size_t)1024 * 128 * 4);
constexpr size_t OFF_MOD = OFF_PART + al256((size_t)KSPLIT * 4 * 12288 * 4);
constexpr size_t OFF_STAT = OFF_MOD + al256((size_t)4 * 12288 * 4);
constexpr size_t OFF_BAR = OFF_STAT + al256((size_t)NTOK * 32 * 4);
constexpr size_t WS_TOTAL = OFF_BAR + al256((size_t)16384 * 4);

struct Params {
    const float *x, *c, *w_ada, *b_ada, *norm1_g, *w_in, *b_gate, *ln_g, *ln_b, *gws, *gbs, *hg_lb, *hg_norm_g,
        *w_bg, *w_bh, *w_out, *norm2_g, *w_ffn_in, *w_ffn_out, *final_g;
    float* out;
    char* ws;
#define WSP(T, name, off) __device__ __forceinline__ T* name() const { return (T*)(ws + (off)); }
    WSP(bf16_t, WaT, OFF_WAT) WSP(bf16_t, WbT, OFF_WBT) WSP(bf16_t, WoutT, OFF_WOUT) WSP(bf16_t, WfiT, OFF_WFI) WSP(bf16_t, WfoT, OFF_WFO)
    WSP(bf16_t, WinT, OFF_R1) WSP(bf16_t, H, OFF_H) WSP(bf16_t, DS, OFF_R1) WSP(float, TB, OFF_R1)
    WSP(bf16_t, UV, OFF_UV) WSP(bf16_t, Y, OFF_UV)
    WSP(bf16_t, QIO, OFF_R2) WSP(float, LF, OFF_LF) WSP(bf16_t, GAB, OFF_GAB) WSP(bf16_t, ACT, OFF_R2)
    WSP(bf16_t, YA, OFF_YA) WSP(bf16_t, YB, OFF_YB) WSP(float, DV, OFF_DV) WSP(float, PART, OFF_PART) WSP(float, MOD, OFF_MOD) WSP(float, STAT, OFF_STAT) WSP(unsigned, BAR, OFF_BAR)
#undef WSP
};

typedef __bf16 bf16v2 __attribute__((ext_vector_type(2)));
__device__ __forceinline__ unsigned cvt_pk_bf16(float lo, float hi) { const f32x2 v = {lo, hi}; return __builtin_bit_cast(unsigned, __builtin_convertvector(v, bf16v2)); }
__device__ __forceinline__ float bf_lo(unsigned w) { return __uint_as_float(w << 16); }
__device__ __forceinline__ float bf_hi(unsigned w) { return __uint_as_float(w & 0xffff0000u); }
__device__ __forceinline__ float bf2f(bf16_t v) { return __uint_as_float(((unsigned)v) << 16); }
__device__ __forceinline__ bf16_t f2bf(float f) { return (bf16_t)(cvt_pk_bf16(f, 0.f) & 0xffffu); }
__device__ __forceinline__ float sigmoidf_(float x) { return __builtin_amdgcn_rcpf(1.0f + __expf(-x)); }
__device__ __forceinline__ float siluf_(float x) { return x * sigmoidf_(x); }
__device__ __forceinline__ float geluf_(float x) { const float y = 1.5957691216f * (x + 0.044715f * x * x * x); return x * sigmoidf_(y); }

__device__ __forceinline__ int lds_byte(int r, int c) { const int st = (r >> 4) * 2 + (c >> 5), rr = r & 15, cc = c & 31, ob = rr * 64 + cc * 2; return st * 1024 + (ob ^ (((ob >> 9) & 1) << 5)); }
__device__ __forceinline__ int perm32(int rho) { const int n = rho >> 4, i = rho & 15; return 8 * (i >> 2) + 4 * n + (i & 3); }
__device__ __forceinline__ void stage_rc(int b, int& R, int& C) { const int st = b / 1024, sb = b % 1024, swz = sb ^ (((sb >> 9) & 1) << 5); R = (st >> 1) * 16 + swz / 64; C = (st & 1) * 32 + (swz % 64) / 2; }

struct Unit { int pm, pn, sel; };
struct Gemm { const bf16_t* A; const bf16_t* Bt; int M, N, K; const bf16_t* A2; const bf16_t* Bt2; };
struct StaticOrder {
    int nM, nN, nwg, G, c;
    __device__ void init(int M, int N, int G_, int c_) { nM = M / BM; nN = N / BM; nwg = nM * nN; G = G_; c = c_; }
    __device__ bool next(int i, Unit& u) const {
        const long L = (long)i * G + c; if (L >= nwg) return false;
        int wgid = (int)L; { const int q = nwg / NXCD, r = nwg % NXCD, xcd = wgid % NXCD, off = wgid / NXCD; wgid = (xcd < r ? xcd * (q + 1) : r * (q + 1) + (xcd - r) * q) + off; }
        const int nig = WGM * nN, gid = wgid / nig, fm = gid * WGM, gsz = (nM - fm) < WGM ? (nM - fm) : WGM;
        u.pm = fm + ((wgid % nig) % gsz); u.pn = (wgid % nig) / gsz; u.sel = 0; return true;
    }
};
struct PairOrder {
    StaticOrder S; int nwg;
    __device__ void init(int M, int N, int G_, int c_) { S.init(M, N, G_, c_); nwg = S.nwg; }
    __device__ bool next(int i, Unit& u) const { if (!S.next(i >> 1, u)) return false; u.sel = i & 1; return true; }
};

#ifndef K_SP2
#define K_SP2 true
#endif
#ifndef K_ALIGN
#define K_ALIGN false
#endif
template <class Epi, class Sched>
__device__ __forceinline__ void gemm_phase(LAS unsigned char* lds, const Gemm g, const Sched& S, const Epi& E) {
    constexpr bool SP2 = K_SP2, ALIGN_EPI = Epi::ALIGN && !Epi::AFTER_DRAIN;
    const int tid = threadIdx.x, wid = __builtin_amdgcn_readfirstlane(tid >> 6), lane = tid & 63, wr = wid >> 2, wc = wid & 3, fr = lane & 15, fq = lane >> 4;
    const int K = g.K, nt = K / BK;
    unsigned voffA[2], voffB[2];
#pragma unroll
    for (int i = 0; i < 2; ++i) { int R, C; stage_rc(tid * 16 + i * 8192, R, C); const int Rb = Epi::PERM ? ((R & ~31) + perm32(R & 31)) : R; voffA[i] = (unsigned)(R * K + C) * 2u; voffB[i] = (unsigned)(Rb * K + C) * 2u; }
    const size_t kstep = (size_t)(BK * 2);
    const size_t hstep = (size_t)HALF * K * 2;
    const size_t tstep = 2 * hstep;
    const unsigned ldsw = (unsigned)wid * 1024u;
    const int aoff = lds_byte(wr * 64 + fr, fq * 8), boff = lds_byte(wc * 32 + fr, fq * 8);
#define PG8_SA(b, h) (((b) * 2 + (h)) * HTB)
#define PG8_SB(b, h) ((4 + (b) * 2 + (h)) * HTB)
#define PG8_STAGE(bufoff, gbase, voff) do { _Pragma("unroll") for (int _i = 0; _i < 2; ++_i) \
        __builtin_amdgcn_global_load_lds((const unsigned*)((const char*)(gbase) + (voff)[_i]), (LAS unsigned*)(lds + (bufoff) + ldsw + _i * 8192), 16, 0, 0); } while (0)
#define PG8_LDA(dst, b, h) do { _Pragma("unroll") for (int m = 0; m < 4; ++m) _Pragma("unroll") for (int k = 0; k < 2; ++k) dst[m][k] = *(const LAS bf16x8*)(lds + PG8_SA(b, h) + aoff + m * 2048 + k * 1024); } while (0)
#define PG8_LDB(dst, b, h) do { _Pragma("unroll") for (int n = 0; n < 2; ++n) _Pragma("unroll") for (int k = 0; k < 2; ++k) dst[n][k] = *(const LAS bf16x8*)(lds + PG8_SB(b, h) + boff + n * 2048 + k * 1024); } while (0)
#define PG8_MMA(ai, bj, At, Bt) do { __builtin_amdgcn_s_setprio(1); _Pragma("unroll") for (int m = 0; m < 4; ++m) _Pragma("unroll") for (int n = 0; n < 2; ++n) _Pragma("unroll") for (int k = 0; k < 2; ++k) \
        acc[ai][bj][m][n] = __builtin_amdgcn_mfma_f32_16x16x32_bf16(Bt[n][k], At[m][k], acc[ai][bj][m][n], 0, 0, 0); __builtin_amdgcn_s_setprio(0); } while (0)
#define PG8_WAIT_V(n) asm volatile("s_waitcnt vmcnt(" #n ")" ::: "memory")
#define PG8_WAIT_L(n) asm volatile("s_waitcnt lgkmcnt(" #n ")" ::: "memory")
#define PG8_BAR __builtin_amdgcn_s_barrier()
#define PG8_SCHED __builtin_amdgcn_sched_barrier(0)
    Unit cur, nxt; int ui = 0;
    if (!S.next(0, cur)) return;
    f32x4 acc[2][2][4][2];
#pragma unroll
    for (int a = 0; a < 2; ++a)
#pragma unroll
        for (int b = 0; b < 2; ++b)
#pragma unroll
            for (int m = 0; m < 4; ++m)
#pragma unroll
                for (int n = 0; n < 2; ++n) acc[a][b][m][n] = (f32x4){0.f, 0.f, 0.f, 0.f};
    bf16x8 At[4][2], B0[2][2], B1[2][2];
    const char* cA = (const char*)((Epi::PAIR && cur.sel) ? g.A2 : g.A) + (size_t)cur.pm * tstep; const char* cB = (const char*)((Epi::PAIR && cur.sel) ? g.Bt2 : g.Bt) + (size_t)cur.pn * tstep;
    if constexpr (SP2) {
        PG8_STAGE(PG8_SB(0, 0), cB, voffB); PG8_STAGE(PG8_SB(0, 1), cB + hstep, voffB); PG8_STAGE(PG8_SA(0, 0), cA, voffA); PG8_STAGE(PG8_SA(0, 1), cA + hstep, voffA);
        if (wr == 1) PG8_BAR;
        PG8_WAIT_V(2); PG8_BAR;
        PG8_STAGE(PG8_SB(1, 0), cB + kstep, voffB); PG8_STAGE(PG8_SA(1, 0), cA + kstep, voffA); PG8_STAGE(PG8_SB(1, 1), cB + hstep + kstep, voffB);
        PG8_WAIT_V(6); PG8_BAR;
    } else {
        PG8_STAGE(PG8_SB(0, 0), cB, voffB); PG8_STAGE(PG8_SA(0, 0), cA, voffA); PG8_STAGE(PG8_SB(0, 1), cB + hstep, voffB); PG8_STAGE(PG8_SA(0, 1), cA + hstep, voffA);
        if (wr == 1) PG8_BAR;
        PG8_WAIT_V(4); PG8_BAR;
        PG8_STAGE(PG8_SB(1, 0), cB + kstep, voffB); PG8_STAGE(PG8_SA(1, 0), cA + kstep, voffA); PG8_STAGE(PG8_SB(1, 1), cB + hstep + kstep, voffB);
        PG8_WAIT_V(6); PG8_BAR;
    }
    for (;;) {
        const bool has_next = S.next(ui + 1, nxt);
        const char* nA = has_next ? (const char*)((Epi::PAIR && nxt.sel) ? g.A2 : g.A) + (size_t)nxt.pm * tstep : cA; const char* nB = has_next ? (const char*)((Epi::PAIR && nxt.sel) ? g.Bt2 : g.Bt) + (size_t)nxt.pn * tstep : cB;
        for (int t = 0; t < nt; t += 2) {
            const bool last = (t == nt - 2);
            const char* a1 = cA + (size_t)(t + 1) * kstep;
            const char* a2 = last ? nA : cA + (size_t)(t + 2) * kstep; const char* b2 = last ? nB : cB + (size_t)(t + 2) * kstep;
            const char* a3 = a2 + kstep; const char* b3 = b2 + kstep;
            if constexpr (SP2) {
            PG8_LDB(B0, 0, 0); PG8_LDB(B1, 0, 1); PG8_SCHED; PG8_LDA(At, 0, 0); PG8_STAGE(PG8_SA(1, 1), a1 + hstep, voffA);
            PG8_WAIT_V(8); PG8_WAIT_L(0); PG8_BAR; PG8_MMA(0, 0, At, B0); PG8_MMA(0, 1, At, B1); PG8_BAR; PG8_SCHED;
            PG8_LDA(At, 0, 1); PG8_STAGE(PG8_SB(0, 0), b2, voffB); PG8_STAGE(PG8_SB(0, 1), b2 + hstep, voffB); PG8_STAGE(PG8_SA(0, 0), a2, voffA);
            PG8_WAIT_V(8); PG8_WAIT_L(0); PG8_BAR; PG8_MMA(1, 0, At, B0); PG8_MMA(1, 1, At, B1); PG8_BAR; PG8_SCHED;
            PG8_LDB(B0, 1, 0); PG8_LDB(B1, 1, 1); PG8_SCHED; PG8_LDA(At, 1, 0); PG8_STAGE(PG8_SA(0, 1), a2 + hstep, voffA);
            PG8_WAIT_V(8); PG8_WAIT_L(0); PG8_BAR; PG8_MMA(0, 0, At, B0); PG8_MMA(0, 1, At, B1); PG8_BAR; PG8_SCHED;
            PG8_LDA(At, 1, 1); PG8_STAGE(PG8_SB(1, 0), b3, voffB); PG8_STAGE(PG8_SB(1, 1), b3 + hstep, voffB); PG8_STAGE(PG8_SA(1, 0), a3, voffA);
            PG8_WAIT_V(8); PG8_WAIT_L(0); PG8_BAR; PG8_MMA(1, 0, At, B0); PG8_MMA(1, 1, At, B1); PG8_BAR; PG8_SCHED;
            } else {
            PG8_LDB(B0, 0, 0); PG8_SCHED; PG8_LDA(At, 0, 0); PG8_STAGE(PG8_SA(1, 1), a1 + hstep, voffA);
            PG8_WAIT_L(8); PG8_BAR; PG8_WAIT_L(0); PG8_MMA(0, 0, At, B0); PG8_BAR; PG8_SCHED;
            PG8_LDB(B1, 0, 1); PG8_STAGE(PG8_SB(0, 0), b2, voffB);
            PG8_BAR; PG8_WAIT_L(0); PG8_MMA(0, 1, At, B1); PG8_BAR;
            PG8_LDA(At, 0, 1); PG8_STAGE(PG8_SA(0, 0), a2, voffA);
            PG8_BAR; PG8_WAIT_L(0); PG8_MMA(1, 0, At, B0); PG8_BAR; PG8_SCHED;
            PG8_STAGE(PG8_SB(0, 1), b2 + hstep, voffB);
            PG8_WAIT_V(6); PG8_BAR; PG8_MMA(1, 1, At, B1); PG8_BAR;
            PG8_LDB(B0, 1, 0); PG8_SCHED; PG8_LDA(At, 1, 0); PG8_STAGE(PG8_SA(0, 1), a2 + hstep, voffA);
            PG8_WAIT_L(8); PG8_BAR; PG8_WAIT_L(0); PG8_MMA(0, 0, At, B0); PG8_BAR; PG8_SCHED;
            PG8_LDB(B1, 1, 1); PG8_STAGE(PG8_SB(1, 0), b3, voffB);
            PG8_BAR; PG8_WAIT_L(0); PG8_MMA(0, 1, At, B1); PG8_BAR;
            PG8_LDA(At, 1, 1); PG8_STAGE(PG8_SA(1, 0), a3, voffA);
            PG8_BAR; PG8_WAIT_L(0); PG8_MMA(1, 0, At, B0); PG8_BAR; PG8_SCHED;
            PG8_STAGE(PG8_SB(1, 1), b3 + hstep, voffB);
            PG8_WAIT_V(6); PG8_BAR; PG8_MMA(1, 1, At, B1); PG8_BAR;
            }
        }
        if constexpr (ALIGN_EPI) { if (wr == 0) PG8_BAR; }
        if constexpr (!Epi::AFTER_DRAIN) E(acc, cur, wr, wc, fr, fq);
        if (!has_next) break;
        if (!(Epi::PAIR && nxt.sel == 1))
#pragma unroll
        for (int a = 0; a < 2; ++a)
#pragma unroll
            for (int b = 0; b < 2; ++b)
#pragma unroll
                for (int m = 0; m < 4; ++m)
#pragma unroll
                    for (int n = 0; n < 2; ++n) acc[a][b][m][n] = (f32x4){0.f, 0.f, 0.f, 0.f};
        cur = nxt; cA = nA; cB = nB; ++ui;
        if constexpr (ALIGN_EPI) { if (wr == 1) PG8_BAR; }
    }
    PG8_WAIT_V(0);
    if constexpr (!ALIGN_EPI) { if (wr == 0) PG8_BAR; }
    PG8_BAR;
    if constexpr (Epi::AFTER_DRAIN) E.fused(acc, cur, wr, wc, fr, fq, lds);
#undef PG8_SA
#undef PG8_SB
#undef PG8_STAGE
#undef PG8_LDA
#undef PG8_LDB
#undef PG8_MMA
#undef PG8_WAIT_V
#undef PG8_WAIT_L
#undef PG8_BAR
#undef PG8_SCHED
}

#define XB_TMO      128
#define XB_XCNT(j)  (256  + 64 * (j))
#define XB_XSUB(j)  (1280 + 64 * (j))
#define XB_XGEN(j)  (2304 + 64 * (j))
#define XB_TOP      3328
#define XB_TOPGEN   3392
#define XCD_BAR_WORDS 3456
#define XB_SPIN_CAP (1u << 18)
__device__ __forceinline__ unsigned xb_ld(unsigned* p)              { return __hip_atomic_load(p, __ATOMIC_RELAXED, __HIP_MEMORY_SCOPE_AGENT); }
__device__ __forceinline__ unsigned xb_add(unsigned* p, unsigned v) { return __hip_atomic_fetch_add(p, v, __ATOMIC_RELAXED, __HIP_MEMORY_SCOPE_AGENT); }
__device__ __forceinline__ unsigned xb_xcc_id() { return (unsigned)__builtin_amdgcn_s_getreg((3 << 11) | 20) & 0xFu; }
#define XB_SPIN(cond, bar) do { unsigned _sp = 0; while (cond) { __builtin_amdgcn_s_sleep(1); \
    if ((++_sp & 255u) == 0u) { if (xb_ld(&(bar)[XB_TMO])) break; if (_sp > XB_SPIN_CAP) { atomicAdd(&(bar)[XB_TMO], 1u); break; } } } } while (0)
struct XcdBarrier { unsigned* bar; unsigned x; volatile LAS unsigned* st; };
__device__ __forceinline__ XcdBarrier xcd_barrier_post(unsigned* bar, volatile LAS unsigned* st) {
    XcdBarrier b; b.bar = bar; b.x = xb_xcc_id(); b.st = st;
    if (threadIdx.x == 0) (void)xb_add(&bar[XB_XCNT(b.x)], 1u);
    return b;
}
__device__ __forceinline__ void xcd_barrier_complete(unsigned* bar, unsigned x, unsigned& nloc, unsigned& nx) {
    const unsigned G = gridDim.x * gridDim.y * gridDim.z;
    unsigned sum, cnt, mine, sp = 0u;
    for (;;) {
        sum = 0u; cnt = 0u; mine = 0u;
#pragma unroll
        for (unsigned j = 0; j < 16; ++j) { const unsigned c = xb_ld(&bar[XB_XCNT(j)]); sum += c; cnt += (c > 0u) ? 1u : 0u; mine = (j == x) ? c : mine; }
        if (sum == G) break;
        __builtin_amdgcn_s_sleep(1);
        if ((++sp & 255u) == 0u) { if (xb_ld(&bar[XB_TMO])) break; if (sp > XB_SPIN_CAP) { atomicAdd(&bar[XB_TMO], 1u); break; } }
    }
    nloc = mine > 0u ? mine : 1u; nx = cnt > 0u ? cnt : 1u;
}
__device__ __forceinline__ void xcd_barrier(const XcdBarrier& b) {
    asm volatile("s_waitcnt vmcnt(0) lgkmcnt(0)" ::: "memory");
    __syncthreads();
    if (threadIdx.x == 0) {
        unsigned* bar = b.bar;
        __builtin_amdgcn_s_waitcnt(0);
        unsigned nloc = b.st[0], nx = b.st[1];
        if (nloc == 0u) { xcd_barrier_complete(bar, b.x, nloc, nx); b.st[0] = nloc; b.st[1] = nx; }
        const unsigned old = xb_add(&bar[XB_XSUB(b.x)], 1u);
        const unsigned gen = old / nloc;
        if (old + 1u == (gen + 1u) * nloc) {
            __builtin_amdgcn_fence(__ATOMIC_RELEASE, "agent");
            asm volatile("s_waitcnt vmcnt(0)" ::: "memory");
            const unsigned og = xb_add(&bar[XB_TOP], 1u);
            const unsigned tg = og / nx;
            if (og + 1u == (tg + 1u) * nx) xb_add(&bar[XB_TOPGEN], 1u);
            else XB_SPIN(xb_ld(&bar[XB_TOPGEN]) == tg, bar);
            __builtin_amdgcn_fence(__ATOMIC_ACQUIRE, "agent");
            xb_add(&bar[XB_XGEN(b.x)], 1u);
            asm volatile("s_waitcnt vmcnt(0)" ::: "memory");
        } else {
            XB_SPIN(xb_ld(&bar[XB_XGEN(b.x)]) == gen, bar);
            __builtin_amdgcn_fence(__ATOMIC_ACQUIRE, "agent");
            asm volatile("s_waitcnt vmcnt(0)" ::: "memory");
        }
    }
    __syncthreads();
}

typedef f32x4 AccT[2][2][4][2];

__device__ __forceinline__ u32x4 pack8(const f32x4 a, const f32x4 b) { u32x4 w; w.x = cvt_pk_bf16(a[0], a[1]); w.y = cvt_pk_bf16(a[2], a[3]); w.z = cvt_pk_bf16(b[0], b[1]); w.w = cvt_pk_bf16(b[2], b[3]); return w; }
__device__ __forceinline__ f32x4 unpk_lo(const u32x4 w) { return (f32x4){bf_lo(w.x), bf_hi(w.x), bf_lo(w.y), bf_hi(w.y)}; }
__device__ __forceinline__ f32x4 unpk_hi(const u32x4 w) { return (f32x4){bf_lo(w.z), bf_hi(w.z), bf_lo(w.w), bf_hi(w.w)}; }
__device__ __forceinline__ f32x4 map4(const f32x4 a, float (*f)(float)) { return (f32x4){f(a[0]), f(a[1]), f(a[2]), f(a[3])}; }
__device__ __forceinline__ f32x4 rcp4(const f32x4 a) { return (f32x4){__builtin_amdgcn_rcpf(a[0]), __builtin_amdgcn_rcpf(a[1]), __builtin_amdgcn_rcpf(a[2]), __builtin_amdgcn_rcpf(a[3])}; }
__device__ __forceinline__ float sum4(const f32x4 a) { return (a[0] + a[1]) + (a[2] + a[3]); }

#ifndef AL_IN
#define AL_IN true
#endif
#ifndef AL_BR
#define AL_BR true
#endif
#ifndef AL_SW
#define AL_SW true
#endif
struct EpiIn {
    static constexpr bool MID = false, AFTER_DRAIN = false, PAIR = false, PERM = true, ALIGN = AL_IN;
    bf16_t *UV, *QIO, *GAB; float *LF, *STAT; const float *b_gate, *hg_lb;
    __device__ __forceinline__ void operator()(const AccT& acc, const Unit& u, int wr, int wc, int fr, int fq) const {
        const int pn = u.pn, row0 = u.pm * BM + wr * 64 + fr, c8 = wc * 32 + 8 * fq, colt = pn * BM;
        if (pn < 8) {
#pragma unroll
            for (int ai = 0; ai < 2; ++ai)
#pragma unroll
                for (int m = 0; m < 4; ++m) {
                    const int row = row0 + ai * HALF + m * 16; float s1 = 0.f, s2 = 0.f;
#pragma unroll
                    for (int bj = 0; bj < 2; ++bj) {
                        const f32x4 v0 = map4(acc[ai][bj][m][0], geluf_), v1 = map4(acc[ai][bj][m][1], geluf_);
                        s1 += sum4(v0) + sum4(v1); s2 += sum4(v0 * v0) + sum4(v1 * v1);
                        *(u32x4*)(UV + (size_t)row * 2048 + colt + bj * HALF + c8) = pack8(v0, v1);
                    }
                    if (pn >= 4) {
                        s1 += __shfl_xor(s1, 16); s1 += __shfl_xor(s1, 32); s2 += __shfl_xor(s2, 16); s2 += __shfl_xor(s2, 32);
                        if (fq == 0) *(f32x2*)(STAT + ((size_t)row * 16 + (pn - 4) * 4 + wc) * 2) = (f32x2){s1, s2};
                    }
                }
        } else if (pn >= 12 && pn < 16) {
            const int cb = colt - 3072;
#pragma unroll
            for (int bj = 0; bj < 2; ++bj) {
                const int col = cb + bj * HALF + c8;
                f32x4 lb[2];
#pragma unroll
                for (int n = 0; n < 2; ++n) { const f32x4 l0 = *(const f32x4*)(hg_lb + col + 4 * n), l1 = *(const f32x4*)(hg_lb + 1024 + col + 4 * n); lb[n] = map4(l0 - l1, sigmoidf_); }
#pragma unroll
                for (int ai = 0; ai < 2; ++ai)
#pragma unroll
                    for (int m = 0; m < 4; ++m) {
                        const int row = row0 + ai * HALF + m * 16;
#pragma unroll
                        for (int n = 0; n < 2; ++n) {
                            const f32x4 sg = map4(acc[ai][bj][m][n], sigmoidf_); const f32x4 f = lb[n] + (1.0f - lb[n]) * sg;
                            *(f32x4*)(LF + (size_t)row * 1024 + col + 4 * n) = (f32x4){__logf(f[0]), __logf(f[1]), __logf(f[2]), __logf(f[3])};
                        }
                    }
            }
        } else if (pn < 24) {
            const int seg = pn >> 2;
            const int cb = (seg == 2) ? colt - 2048 : (seg == 4) ? colt - 4096 + 1024 : colt - 5120 + 2048;
            const bool act = (seg != 4);
#pragma unroll
            for (int ai = 0; ai < 2; ++ai)
#pragma unroll
                for (int m = 0; m < 4; ++m) {
                    const int row = row0 + ai * HALF + m * 16;
#pragma unroll
                    for (int bj = 0; bj < 2; ++bj) {
                        f32x4 a0 = acc[ai][bj][m][0], a1 = acc[ai][bj][m][1];
                        if (act) { a0 = map4(a0, siluf_); a1 = map4(a1, siluf_); }
                        *(u32x4*)(QIO + (size_t)row * 3072 + cb + bj * HALF + c8) = pack8(a0, a1);
                    }
                }
        } else {
            const int cb = colt - 6144;
#pragma unroll
            for (int bj = 0; bj < 2; ++bj) {
                const int col = cb + bj * HALF + c8; const f32x4 bg0 = *(const f32x4*)(b_gate + col), bg1 = *(const f32x4*)(b_gate + col + 4);
#pragma unroll
                for (int ai = 0; ai < 2; ++ai)
#pragma unroll
                    for (int m = 0; m < 4; ++m) {
                        const int row = row0 + ai * HALF + m * 16;
                        *(u32x4*)(GAB + (size_t)row * 4096 + col) = pack8(map4(acc[ai][bj][m][0] + bg0, sigmoidf_), map4(acc[ai][bj][m][1] + bg1, sigmoidf_));
                    }
            }
        }
    }
};

struct EpiBrPair {
    static constexpr bool MID = false, AFTER_DRAIN = false, PAIR = true, PERM = true, ALIGN = AL_BR;
    const bf16_t* GAB; bf16_t* Y; unsigned* cnt3; unsigned* bar;
    __device__ __forceinline__ void operator()(AccT& acc, const Unit& u, int wr, int wc, int fr, int fq) const {
        const int row0 = u.pm * BM + wr * 64 + fr, col0 = u.pn * BM + wc * 32 + 8 * fq;
        const __amdgpu_buffer_rsrc_t rY = __builtin_amdgcn_make_buffer_rsrc((void*)Y, (short)0, (int)((size_t)NTOK * 2048 * 2), 0x00020000);
#pragma unroll
        for (int ai = 0; ai < 2; ++ai)
#pragma unroll
            for (int m = 0; m < 4; ++m) {
                const size_t row = (size_t)(row0 + ai * HALF + m * 16);
#pragma unroll
                for (int bj = 0; bj < 2; ++bj) {
                    const int col = col0 + bj * HALF;
                    const u32x4 b = __builtin_nontemporal_load((const u32x4*)(GAB + row * 4096 + 2048 + col));
                    if (u.sel == 0) {
                        const u32x4 a = __builtin_nontemporal_load((const u32x4*)(GAB + row * 4096 + col));
                        acc[ai][bj][m][0] *= unpk_lo(a) * rcp4(unpk_lo(b)); acc[ai][bj][m][1] *= unpk_hi(a) * rcp4(unpk_hi(b));
                    } else {
                        __builtin_amdgcn_raw_buffer_store_b128(pack8(acc[ai][bj][m][0] * unpk_lo(b), acc[ai][bj][m][1] * unpk_hi(b)), rY, (unsigned)((row * 2048 + col) * 2), 0, 16);
                    }
                }
            }
        if (cnt3 && u.sel == 1) {
            asm volatile("s_waitcnt vmcnt(0)" ::: "memory");
            __syncthreads();
            if (threadIdx.x == 0) {
                unsigned* cw = cnt3 + 64 * u.pm;
                (void)xb_add(cw, 1u);
                XB_SPIN(xb_ld(cw) < 8u, bar);
                __builtin_amdgcn_fence(__ATOMIC_ACQUIRE, "agent");
                asm volatile("s_waitcnt vmcnt(0)" ::: "memory");
            }
            __syncthreads();
        }
    }
};

struct EpiRes {
    static constexpr bool MID = false, AFTER_DRAIN = false, PAIR = false, PERM = true, ALIGN = false;
    const float* src; float* dst; const float* gate;
    __device__ __forceinline__ void operator()(const AccT& acc, const Unit& u, int wr, int wc, int fr, int fq) const {
        const int row0 = u.pm * BM + wr * 64 + fr, col0 = u.pn * BM + wc * 32 + 8 * fq;
        const int b = (u.pm * BM) / SEQ;
        f32x4 gv[2][2];
#pragma unroll
        for (int bj = 0; bj < 2; ++bj)
#pragma unroll
            for (int n = 0; n < 2; ++n) gv[bj][n] = *(const f32x4*)(gate + (size_t)b * 12288 + col0 + bj * HALF + 4 * n);
#pragma unroll
        for (int ai = 0; ai < 2; ++ai)
#pragma unroll
            for (int m = 0; m < 4; ++m) {
                const size_t ro = (size_t)(row0 + ai * HALF + m * 16) * 2048 + col0;
#pragma unroll
                for (int bj = 0; bj < 2; ++bj)
#pragma unroll
                    for (int n = 0; n < 2; ++n) {
                        const f32x4 xv = *(const f32x4*)(src + ro + bj * HALF + 4 * n);
                        *(f32x4*)(dst + ro + bj * HALF + 4 * n) = xv + gv[bj][n] * acc[ai][bj][m][n];
                    }
            }
    }
};

template <bool FINAL> struct EpiResNorm {
    static constexpr bool MID = false, AFTER_DRAIN = true, PAIR = false, PERM = true, ALIGN = false;
    const float* src; float* dst; const float* gate; const float* g; const float* modsh; const float* modsc; bf16_t* H; float* PST; unsigned* cnt; unsigned* bar; unsigned* cnt2;
    __device__ __forceinline__ void operator()(const AccT&, const Unit&, int, int, int, int) const {}
    __device__ __forceinline__ void fused(AccT& acc, const Unit& u, int wr, int wc, int fr, int fq, LAS unsigned char* lds) const {
        const int row0 = u.pm * BM + wr * 64 + fr, col0 = u.pn * BM + wc * 32 + 8 * fq;
        const int b = (u.pm * BM) / SEQ;
        {
            f32x4 gv[2][2];
#pragma unroll
            for (int bj = 0; bj < 2; ++bj)
#pragma unroll
                for (int n = 0; n < 2; ++n) gv[bj][n] = *(const f32x4*)(gate + (size_t)b * 12288 + col0 + bj * HALF + 4 * n);
#pragma unroll
            for (int ai = 0; ai < 2; ++ai)
#pragma unroll
                for (int m = 0; m < 4; ++m) {
                    const int row = row0 + ai * HALF + m * 16; const size_t ro = (size_t)row * 2048 + col0; float s = 0.f;
#pragma unroll
                    for (int bj = 0; bj < 2; ++bj)
#pragma unroll
                        for (int n = 0; n < 2; ++n) {
                            const f32x4 v = __builtin_nontemporal_load((const f32x4*)(src + ro + bj * HALF + 4 * n)) + gv[bj][n] * acc[ai][bj][m][n];
                            acc[ai][bj][m][n] = v; s += sum4(v * v);
                        }
                    s += __shfl_xor(s, 16); s += __shfl_xor(s, 32);
                    if (fq == 0) __hip_atomic_store(PST + (size_t)row * 32 + u.pn * 4 + wc, s, __ATOMIC_RELAXED, __HIP_MEMORY_SCOPE_AGENT);
                }
        }
        asm volatile("s_waitcnt vmcnt(0)" ::: "memory");
        __syncthreads();
        if (threadIdx.x == 0) (void)xb_add(cnt + 64 * u.pm, 1u);
        if (!FINAL) {
#pragma unroll
            for (int ai = 0; ai < 2; ++ai)
#pragma unroll
                for (int m = 0; m < 4; ++m) {
                    const size_t ro = (size_t)(row0 + ai * HALF + m * 16) * 2048 + col0;
#pragma unroll
                    for (int bj = 0; bj < 2; ++bj)
#pragma unroll
                        for (int n = 0; n < 2; ++n) *(f32x4*)(dst + ro + bj * HALF + 4 * n) = acc[ai][bj][m][n];
                }
        }
        if (threadIdx.x == 0) {
            unsigned* cw = cnt + 64 * u.pm;
            XB_SPIN(xb_ld(cw) < 8u, bar);
            __builtin_amdgcn_fence(__ATOMIC_ACQUIRE, "agent");
            asm volatile("s_waitcnt vmcnt(0)" ::: "memory");
        }
        __syncthreads();
        LAS float* R = (LAS float*)lds;
        if (threadIdx.x < 256) {
            const float* ps = PST + (size_t)(u.pm * BM + threadIdx.x) * 32; float s = 0.f;
#pragma unroll
            for (int i = 0; i < 8; ++i) s += sum4(*(const f32x4*)(ps + 4 * i));
            R[threadIdx.x] = rsqrtf(s * (1.0f / 2048.0f) + EPSF);
        }
        __syncthreads();
        const __amdgpu_buffer_rsrc_t rH = __builtin_amdgcn_make_buffer_rsrc((void*)H, (short)0, (int)((size_t)NTOK * 2048 * 2), 0x00020000);
        f32x4 gg[2][2], sv[2][2];
#pragma unroll
        for (int bj = 0; bj < 2; ++bj)
#pragma unroll
            for (int n = 0; n < 2; ++n) {
                const int col = col0 + bj * HALF + 4 * n; gg[bj][n] = *(const f32x4*)(g + col);
                if (!FINAL) { gg[bj][n] *= (*(const f32x4*)(modsc + (size_t)b * 12288 + col) + 1.0f); sv[bj][n] = *(const f32x4*)(modsh + (size_t)b * 12288 + col); }
            }
#pragma unroll
        for (int ai = 0; ai < 2; ++ai)
#pragma unroll
            for (int m = 0; m < 4; ++m) {
                const int rl = wr * 64 + ai * HALF + m * 16 + fr; const float r = R[rl]; const size_t ro = (size_t)(u.pm * BM + rl) * 2048 + col0;
#pragma unroll
                for (int bj = 0; bj < 2; ++bj) {
                    if (FINAL) {
#pragma unroll
                        for (int n = 0; n < 2; ++n) *(f32x4*)(dst + ro + bj * HALF + 4 * n) = acc[ai][bj][m][n] * r * gg[bj][n];
                    } else __builtin_amdgcn_raw_buffer_store_b128(pack8(acc[ai][bj][m][0] * r * gg[bj][0] + sv[bj][0], acc[ai][bj][m][1] * r * gg[bj][1] + sv[bj][1]), rH, (unsigned)((ro + bj * HALF) * 2), 0, 16);
                }
            }
        if (!FINAL && cnt2) {
            asm volatile("s_waitcnt vmcnt(0)" ::: "memory");
            __syncthreads();
            if (threadIdx.x == 0) {
                unsigned* cw = cnt2 + 64 * u.pm;
                (void)xb_add(cw, 1u);
                XB_SPIN(xb_ld(cw) < 8u, bar);
                __builtin_amdgcn_fence(__ATOMIC_ACQUIRE, "agent");
                asm volatile("s_waitcnt vmcnt(0)" ::: "memory");
            }
            __syncthreads();
        }
    }
};

struct EpiSwi {
    static constexpr bool MID = false, AFTER_DRAIN = false, PAIR = false, PERM = true, ALIGN = AL_SW;
    bf16_t* ACT;
    __device__ __forceinline__ void operator()(const AccT& acc, const Unit& u, int wr, int wc, int fr, int fq) const {
        const int row0 = u.pm * BM + wr * 64 + fr, col0 = u.pn * HALF + wc * 32 + 8 * fq;
#pragma unroll
        for (int ai = 0; ai < 2; ++ai)
#pragma unroll
            for (int m = 0; m < 4; ++m)
                *(u32x4*)(ACT + (size_t)(row0 + ai * HALF + m * 16) * FH + col0) =
                    pack8(map4(acc[ai][0][m][0], siluf_) * acc[ai][1][m][0], map4(acc[ai][0][m][1], siluf_) * acc[ai][1][m][1]);
    }
};

__device__ __forceinline__ bf16x8 frag_row(const LAS unsigned char* X, int ldb, int r0, int k0, int fr, int fq) { return *(const LAS bf16x8*)(X + (r0 + fr) * ldb + (k0 + 8 * fq) * 2); }
__device__ __forceinline__ bf16x8 frag_tr(const LAS unsigned char* X, int ldb, int r0, int k0, int fr, int fq) {
    const LAS unsigned char* a = X + (k0 + 8 * fq + (fr >> 2)) * ldb + (r0 + 4 * (fr & 3)) * 2;
    const s16x4 lo = __builtin_amdgcn_ds_read_tr16_b64_v4i16((LAS s16x4*)a), hi = __builtin_amdgcn_ds_read_tr16_b64_v4i16((LAS s16x4*)(a + 4 * ldb));
    return (bf16x8){lo[0], lo[1], lo[2], lo[3], hi[0], hi[1], hi[2], hi[3]};
}
__device__ __forceinline__ f32x4 mma(bf16x8 fn, bf16x8 fm, f32x4 acc) { return __builtin_amdgcn_mfma_f32_16x16x32_bf16(fn, fm, acc, 0, 0, 0); }

constexpr int LD136 = 272;

struct TDesc { const float* src; bf16_t* dst; int N, ldd, mode, k0, n0; };
constexpr int TT0 = 16 * 80, TT1 = TT0 + 8 * 16, TT2 = TT1 + 8 * 16, TT3 = TT2 + 16 * 16, TT4 = TT3 + 16 * 88, TT5 = TT4 + 44 * 16;
__device__ __forceinline__ void tdesc(const Params& p, int t, TDesc& d) {
    int loc;
    if (t < TT0) { d.src = p.w_in; d.dst = p.WinT(); d.N = INW; d.ldd = 2048; d.mode = 0; loc = t; }
    else if (t < TT1) { d.src = p.w_bg; d.dst = p.WaT(); d.N = 2048; d.ldd = 1024; d.mode = 0; loc = t - TT0; }
    else if (t < TT2) { d.src = p.w_bh; d.dst = p.WbT(); d.N = 2048; d.ldd = 1024; d.mode = 0; loc = t - TT1; }
    else if (t < TT3) { d.src = p.w_out; d.dst = p.WoutT(); d.N = 2048; d.ldd = 2048; d.mode = 0; loc = t - TT2; }
    else if (t < TT4) { d.src = p.w_ffn_in; d.dst = p.WfiT(); d.N = 2 * FH; d.ldd = 2048; d.mode = 1; loc = t - TT3; }
    else { d.src = p.w_ffn_out; d.dst = p.WfoT(); d.N = 2048; d.ldd = FH; d.mode = 0; loc = t - TT4; }
    const int ntn = d.N / 128; d.k0 = (loc / ntn) * 128; d.n0 = (loc % ntn) * 128;
}
typedef f32x4 TileRegs[2][2][2];
__device__ __forceinline__ void tile_load(const TDesc& d, TileRegs& r) {
    const int nl = threadIdx.x & 15, kp = threadIdx.x >> 4;
#pragma unroll
    for (int hf = 0; hf < 2; ++hf)
#pragma unroll
        for (int ps = 0; ps < 2; ++ps) {
            const float* s = d.src + (size_t)(d.k0 + 2 * (ps * 32 + kp)) * d.N + d.n0 + hf * 64 + 4 * nl;
            r[hf][ps][0] = __builtin_nontemporal_load((const f32x4*)s); r[hf][ps][1] = __builtin_nontemporal_load((const f32x4*)(s + d.N));
        }
}
__device__ __forceinline__ void tile_to_lds(LAS unsigned* tl, const TileRegs& r) {
    const int nl = threadIdx.x & 15, kp = threadIdx.x >> 4;
#pragma unroll
    for (int hf = 0; hf < 2; ++hf)
#pragma unroll
        for (int ps = 0; ps < 2; ++ps)
#pragma unroll
            for (int j = 0; j < 4; ++j) tl[(hf * 64 + 4 * nl + j) * 65 + ps * 32 + kp] = cvt_pk_bf16(r[hf][ps][0][j], r[hf][ps][1][j]);
}
__device__ __forceinline__ void tile_store(const LAS unsigned* tl, const TDesc& d) {
    const int dq = threadIdx.x & 15;
#pragma unroll
    for (int ps = 0; ps < 4; ++ps) {
        const int n = ps * 32 + (threadIdx.x >> 4); u32x4 w;
        w.x = tl[n * 65 + 4 * dq + 0]; w.y = tl[n * 65 + 4 * dq + 1]; w.z = tl[n * 65 + 4 * dq + 2]; w.w = tl[n * 65 + 4 * dq + 3];
        int gn = d.n0 + n;
        if (d.mode == 1) { const int part = gn >= FH ? 1 : 0, h = gn - part * FH; gn = (h >> 7) * 256 + part * 128 + (h & 127); }
        *(u32x4*)(d.dst + (size_t)gn * d.ldd + d.k0 + 8 * dq) = w;
    }
}
__device__ __forceinline__ void transpose_tiles(const Params& p, LAS unsigned char* lds, int first, int stride, int t_begin, int t_end) {
    LAS unsigned* tl0 = (LAS unsigned*)lds; LAS unsigned* tl1 = tl0 + 128 * 65;
    int t = t_begin + first, buf = 0;
    TDesc cur, nxt; TileRegs r, rn;
    if (t < t_end) { tdesc(p, t, cur); tile_load(cur, r); }
    while (t < t_end) {
        const int tn = t + stride; const bool hn = tn < t_end;
        if (hn) { tdesc(p, tn, nxt); tile_load(nxt, rn); }
        LAS unsigned* tl = buf ? tl1 : tl0;
        tile_to_lds(tl, r);
        __syncthreads();
        tile_store(tl, cur);
        if (hn) {
            cur = nxt;
#pragma unroll
            for (int a = 0; a < 2; ++a)
#pragma unroll
                for (int b = 0; b < 2; ++b) { r[a][b][0] = rn[a][b][0]; r[a][b][1] = rn[a][b][1]; }
        }
        t = tn; buf ^= 1;
    }
    __syncthreads();
}

__device__ void phase0(const Params& p, LAS unsigned char* lds) {
    const int tid = threadIdx.x;
    LAS float* cact = (LAS float*)lds;
    {
        float cv[16];
#pragma unroll
        for (int i = 0; i < 16; ++i) cv[i] = p.c[tid + 512 * i];
#pragma unroll
        for (int i = 0; i < 16; ++i) cact[tid + 512 * i] = siluf_(cv[i]);
    }
    __syncthreads();
    for (int task = blockIdx.x * 512 + tid; task < 3072 * KSPLIT; task += gridDim.x * 512) {
        const int cg4 = task % 3072, ks = task / 3072;
        const float* w = p.w_ada + (size_t)(ks * 64) * 12288 + cg4 * 4;
        f32x4 a0 = {0.f, 0.f, 0.f, 0.f}, a1 = a0, a2 = a0, a3 = a0;
#pragma unroll 16
        for (int k = 0; k < 64; ++k) {
            const f32x4 wv = __builtin_nontemporal_load((const f32x4*)(w + (size_t)k * 12288)); const int kk = ks * 64 + k;
            a0 += wv * cact[kk]; a1 += wv * cact[2048 + kk]; a2 += wv * cact[4096 + kk]; a3 += wv * cact[6144 + kk];
        }
        const __amdgpu_buffer_rsrc_t rp = __builtin_amdgcn_make_buffer_rsrc((void*)p.PART(), (short)0, (int)((size_t)KSPLIT * 4 * 12288 * 4), 0x00020000);
        const unsigned pp = (unsigned)(((size_t)(ks * 4) * 12288 + cg4 * 4) * 4);
        __builtin_amdgcn_raw_buffer_store_b128(__builtin_bit_cast(u32x4, a0), rp, pp, 0, 16); __builtin_amdgcn_raw_buffer_store_b128(__builtin_bit_cast(u32x4, a1), rp, pp + 12288u * 4u, 0, 16);
        __builtin_amdgcn_raw_buffer_store_b128(__builtin_bit_cast(u32x4, a2), rp, pp + 2u * 12288u * 4u, 0, 16); __builtin_amdgcn_raw_buffer_store_b128(__builtin_bit_cast(u32x4, a3), rp, pp + 3u * 12288u * 4u, 0, 16);
    }
    asm volatile("s_waitcnt vmcnt(0)" ::: "memory");
    __syncthreads();
    if ((int)blockIdx.x * 512 < 3072 * KSPLIT && tid == 0) (void)xb_add(p.BAR() + GEMV_CNT, 1u);
    transpose_tiles(p, lds, (int)blockIdx.x, (int)gridDim.x, 0, TT2);
}

__device__ void phase_norm(const Params& p, LAS unsigned char* lds, int mode) {
    const int tid = threadIdx.x, wid = tid >> 6, lane = tid & 63;
    LAS float* gsc = (LAS float*)lds; LAS float* shf = gsc + 2048;
    if (mode == 0) {
        for (int e = blockIdx.x * 512 + tid; e < NB * 12288; e += gridDim.x * 512) {
            const int b = e / 12288, n = e % 12288; float s = p.b_ada[n];
            float pv[KSPLIT];
#pragma unroll
            for (int ks = 0; ks < KSPLIT; ++ks) pv[ks] = p.PART()[(size_t)(ks * 4 + b) * 12288 + n];
#pragma unroll
            for (int ks = 0; ks < KSPLIT; ++ks) s += pv[ks];
            p.MOD()[e] = s;
        }
    }
    const float* src = (mode == 0) ? p.x : p.out;
    const float* g = (mode == 0) ? p.norm1_g : (mode == 1) ? p.norm2_g : p.final_g;
    for (int rg = blockIdx.x; rg < NTOK / 32; rg += gridDim.x) {
        const int b = rg / (SEQ / 32);
        f32x4 xv[4][8];
#pragma unroll
        for (int rr = 0; rr < 4; ++rr)
#pragma unroll
            for (int i = 0; i < 8; ++i) xv[rr][i] = __builtin_nontemporal_load((const f32x4*)(src + ((size_t)rg * 32 + wid * 4 + rr) * 2048 + i * 256 + lane * 4));
        __syncthreads();
        for (int d = tid; d < DM; d += 512) {
            float sh = 0.f, sc = 0.f;
            if (mode == 0) {
                sh = p.b_ada[d]; sc = p.b_ada[2048 + d];
                float p0[KSPLIT], p1[KSPLIT];
#pragma unroll
                for (int ks = 0; ks < KSPLIT; ++ks) { const float* pp = p.PART() + (size_t)(ks * 4 + b) * 12288; p0[ks] = pp[d]; p1[ks] = pp[2048 + d]; }
#pragma unroll
                for (int ks = 0; ks < KSPLIT; ++ks) { sh += p0[ks]; sc += p1[ks]; }
            } else if (mode == 1) { sh = p.MOD()[(size_t)b * 12288 + 3 * 2048 + d]; sc = p.MOD()[(size_t)b * 12288 + 4 * 2048 + d]; }
            gsc[d] = g[d] * (1.0f + sc); shf[d] = sh;
        }
        __syncthreads();
#pragma unroll
        for (int rr = 0; rr < 4; ++rr) {
            const size_t row = (size_t)rg * 32 + wid * 4 + rr;
            float ss = 0.f;
#pragma unroll
            for (int i = 0; i < 8; ++i) ss += (xv[rr][i][0] * xv[rr][i][0] + xv[rr][i][1] * xv[rr][i][1]) + (xv[rr][i][2] * xv[rr][i][2] + xv[rr][i][3] * xv[rr][i][3]);
#pragma unroll
            for (int o = 1; o < 64; o <<= 1) ss += __shfl_xor(ss, o);
            const float r = rsqrtf(ss * (1.0f / 2048.0f) + EPSF);
#pragma unroll
            for (int i = 0; i < 8; ++i) {
                const int col = i * 256 + lane * 4; const f32x4 gg = *(const LAS f32x4*)(gsc + col), sv = *(const LAS f32x4*)(shf + col);
                const f32x4 h = xv[rr][i] * r * gg + sv;
                if (mode == 2) *(f32x4*)(p.out + row * 2048 + col) = h;
                else { u32x2 w; w.x = cvt_pk_bf16(h[0], h[1]); w.y = cvt_pk_bf16(h[2], h[3]); *(u32x2*)(p.H() + row * 2048 + col) = w; }
            }
        }
    }
}

__device__ void gmlp_unit(const Params& p, LAS unsigned char* lds, int bc, int g) {
    const int tid = threadIdx.x, wid = tid >> 6, lane = tid & 63, fr = lane & 15, fq = lane >> 4;
    LAS unsigned char* Wm = lds; LAS unsigned char* VN = lds + 128 * LD136; LAS float* MR = (LAS float*)(lds + 2 * 128 * LD136);
    const int tok0 = bc * 128;
    const int t0 = (wid >> 2) * 64, d0 = (wid & 3) * 32;
    u32x4 vraw[4]; f32x4 wreg[8]; u32x2 ureg[4][2]; float bsv[4]; f32x4 st[8];
#pragma unroll
    for (int i = 0; i < 4; ++i) { const int idx = tid + 512 * i, s = idx >> 4, c8 = (idx & 15) * 8; vraw[i] = __builtin_nontemporal_load((const u32x4*)(p.UV() + (size_t)(tok0 + s) * 2048 + 1024 + g * 128 + c8)); }
    if (tid < 128) {
#pragma unroll
        for (int i = 0; i < 8; ++i) st[i] = __builtin_nontemporal_load((const f32x4*)(p.STAT() + (size_t)(tok0 + tid) * 32 + 4 * i));
    }
    {
        const float* W = p.gws + (size_t)g * 16384;
#pragma unroll
        for (int i = 0; i < 8; ++i) { const int idx = tid + 512 * i; wreg[i] = *(const f32x4*)(W + (idx >> 5) * 128 + (idx & 31) * 4); }
    }
#pragma unroll
    for (int m = 0; m < 4; ++m) {
        const int t = t0 + m * 16 + fr; bsv[m] = p.gbs[g * 128 + t];
#pragma unroll
        for (int n = 0; n < 2; ++n) ureg[m][n] = __builtin_nontemporal_load((const u32x2*)(p.UV() + (size_t)(tok0 + t) * 2048 + g * 128 + d0 + n * 16 + 4 * fq));
    }
    if (tid < 128) {
        float s1 = 0.f, s2 = 0.f;
#pragma unroll
        for (int i = 0; i < 8; ++i) { s1 += st[i][0] + st[i][2]; s2 += st[i][1] + st[i][3]; }
        const float mu = s1 * (1.0f / 1024.0f), var = s2 * (1.0f / 1024.0f) - mu * mu;
        MR[2 * tid] = mu; MR[2 * tid + 1] = rsqrtf(var + EPSF);
    }
#pragma unroll
    for (int i = 0; i < 8; ++i) {
        const int idx = tid + 512 * i, t = idx >> 5, s4 = (idx & 31) * 4; f32x4 w = wreg[i];
#pragma unroll
        for (int j = 0; j < 4; ++j) w[j] = (s4 + j <= t) ? w[j] : 0.f;
        u32x2 o; o.x = cvt_pk_bf16(w[0], w[1]); o.y = cvt_pk_bf16(w[2], w[3]);
        *(LAS u32x2*)(Wm + t * LD136 + s4 * 2) = o;
    }
    __syncthreads();
#pragma unroll
    for (int i = 0; i < 4; ++i) {
        const int idx = tid + 512 * i, s = idx >> 4, c8 = (idx & 15) * 8, ch = g * 128 + c8;
        const u32x4 raw = vraw[i];
        const float mu = MR[2 * s], rs = MR[2 * s + 1];
        const f32x4 g0 = *(const f32x4*)(p.ln_g + ch), g1 = *(const f32x4*)(p.ln_g + ch + 4), b0 = *(const f32x4*)(p.ln_b + ch), b1 = *(const f32x4*)(p.ln_b + ch + 4);
        u32x4 o;
        o.x = cvt_pk_bf16((bf_lo(raw.x) - mu) * rs * g0[0] + b0[0], (bf_hi(raw.x) - mu) * rs * g0[1] + b0[1]);
        o.y = cvt_pk_bf16((bf_lo(raw.y) - mu) * rs * g0[2] + b0[2], (bf_hi(raw.y) - mu) * rs * g0[3] + b0[3]);
        o.z = cvt_pk_bf16((bf_lo(raw.z) - mu) * rs * g1[0] + b1[0], (bf_hi(raw.z) - mu) * rs * g1[1] + b1[1]);
        o.w = cvt_pk_bf16((bf_lo(raw.w) - mu) * rs * g1[2] + b1[2], (bf_hi(raw.w) - mu) * rs * g1[3] + b1[3]);
        *(LAS u32x4*)(VN + s * LD136 + c8 * 2) = o;
    }
    __syncthreads();
    f32x4 acc[4][2];
#pragma unroll
    for (int m = 0; m < 4; ++m) { acc[m][0] = (f32x4){0.f, 0.f, 0.f, 0.f}; acc[m][1] = acc[m][0]; }
#pragma unroll
    for (int ks = 0; ks < 4; ++ks) {
        bf16x8 fn[2], fm[4];
#pragma unroll
        for (int n = 0; n < 2; ++n) fn[n] = frag_tr(VN, LD136, d0 + n * 16, ks * 32, fr, fq);
#pragma unroll
        for (int m = 0; m < 4; ++m) fm[m] = frag_row(Wm, LD136, t0 + m * 16, ks * 32, fr, fq);
#pragma unroll
        for (int m = 0; m < 4; ++m)
#pragma unroll
            for (int n = 0; n < 2; ++n) acc[m][n] = mma(fn[n], fm[m], acc[m][n]);
    }
#pragma unroll
    for (int m = 0; m < 4; ++m) {
        const int t = t0 + m * 16 + fr; const size_t tok = (size_t)(tok0 + t); const float bs = bsv[m];
#pragma unroll
        for (int n = 0; n < 2; ++n) {
            const int ch = g * 128 + d0 + n * 16 + 4 * fq;
            const u32x2 uu = ureg[m][n]; const f32x4 a = acc[m][n];
            u32x2 w; w.x = cvt_pk_bf16((a[0] + bs) * bf_lo(uu.x), (a[1] + bs) * bf_hi(uu.x)); w.y = cvt_pk_bf16((a[2] + bs) * bf_lo(uu.y), (a[3] + bs) * bf_hi(uu.y));
            *(u32x2*)(p.YA() + tok * 1024 + ch) = w;
        }
    }
    __syncthreads();
}

__device__ void hgrn_a_unit(const Params& p, LAS unsigned char* lds, int bh, int c) {
    const int tid = threadIdx.x, wid = tid >> 6, lane = tid & 63, fr = lane & 15, fq = lane >> 4;
    LAS unsigned char* Is = lds; LAS unsigned char* Ks = lds + 64 * LD136; LAS float* SEG = (LAS float*)(lds + 2 * 64 * LD136);
    const int b = bh >> 3, h = bh & 7, tok0 = b * SEQ + c * 64;
#pragma unroll
    for (int i = 0; i < 2; ++i) {
        const int idx = tid + 512 * i, s = idx >> 4, c8 = (idx & 15) * 8;
        *(LAS u32x4*)(Is + s * LD136 + c8 * 2) = __builtin_nontemporal_load((const u32x4*)(p.QIO() + (size_t)(tok0 + s) * 3072 + 1024 + h * 128 + c8));
    }
    const int k = tid & 127, seg = tid >> 7;
    float v[16], kk[16];
#pragma unroll
    for (int i = 0; i < 16; ++i) { v[i] = __builtin_nontemporal_load(p.LF() + (size_t)(tok0 + seg * 16 + i) * 1024 + h * 128 + k); kk[i] = 1.0f - __expf(v[i]); }
#pragma unroll
    for (int i = 1; i < 16; ++i) v[i] += v[i - 1];
    SEG[seg * 128 + k] = v[15];
    __syncthreads();
    float off = 0.f, tot = 0.f;
#pragma unroll
    for (int s = 0; s < 4; ++s) { const float sv = SEG[s * 128 + k]; tot += sv; if (s < seg) off += sv; }
#pragma unroll
    for (int i = 0; i < 16; ++i) { const float bb = v[i] + off; *(LAS bf16_t*)(Ks + (seg * 16 + i) * LD136 + k * 2) = f2bf(kk[i] * __expf(tot - bb)); }
    if (seg == 0) p.DV()[(size_t)(bh * 32 + c) * 128 + k] = __expf(tot);
    __syncthreads();
    const int v0 = (wid >> 2) * 64, k0 = (wid & 3) * 32;
    f32x4 acc[4][2];
#pragma unroll
    for (int m = 0; m < 4; ++m) { acc[m][0] = (f32x4){0.f, 0.f, 0.f, 0.f}; acc[m][1] = acc[m][0]; }
#pragma unroll
    for (int ks = 0; ks < 2; ++ks) {
        bf16x8 fn[2], fm[4];
#pragma unroll
        for (int n = 0; n < 2; ++n) fn[n] = frag_tr(Ks, LD136, k0 + n * 16, ks * 32, fr, fq);
#pragma unroll
        for (int m = 0; m < 4; ++m) fm[m] = frag_tr(Is, LD136, v0 + m * 16, ks * 32, fr, fq);
#pragma unroll
        for (int m = 0; m < 4; ++m)
#pragma unroll
            for (int n = 0; n < 2; ++n) acc[m][n] = mma(fn[n], fm[m], acc[m][n]);
    }
    bf16_t* ds = p.DS() + (size_t)(bh * 32 + c) * 16384;
#pragma unroll
    for (int m = 0; m < 4; ++m)
#pragma unroll
        for (int n = 0; n < 2; ++n) { u32x2 w; w.x = cvt_pk_bf16(acc[m][n][0], acc[m][n][1]); w.y = cvt_pk_bf16(acc[m][n][2], acc[m][n][3]); *(u32x2*)(ds + (v0 + m * 16 + fr) * 128 + k0 + n * 16 + 4 * fq) = w; }
    __syncthreads();
}

__device__ void hgrn_scan(const Params& p) {
    for (int e = blockIdx.x * 512 + threadIdx.x; e < 32 * 2048; e += gridDim.x * 512) {
        const int bh = e >> 11, q8 = e & 2047, k = (q8 & 15) * 8;
        bf16_t* base = p.DS() + (size_t)bh * 32 * 16384 + q8 * 8; const float* dv = p.DV() + (size_t)bh * 32 * 128 + k;
        float S[8];
#pragma unroll
        for (int j = 0; j < 8; ++j) S[j] = 0.f;
        for (int c0 = 0; c0 < 32; c0 += 8) {
            u32x4 dl[8]; f32x4 d0[8], d1[8];
#pragma unroll
            for (int j = 0; j < 8; ++j) { dl[j] = __builtin_nontemporal_load((const u32x4*)(base + (size_t)(c0 + j) * 16384)); d0[j] = *(const f32x4*)(dv + (c0 + j) * 128); d1[j] = *(const f32x4*)(dv + (c0 + j) * 128 + 4); }
#pragma unroll
            for (int j = 0; j < 8; ++j) {
                u32x4 o; o.x = cvt_pk_bf16(S[0], S[1]); o.y = cvt_pk_bf16(S[2], S[3]); o.z = cvt_pk_bf16(S[4], S[5]); o.w = cvt_pk_bf16(S[6], S[7]);
                *(u32x4*)(base + (size_t)(c0 + j) * 16384) = o;
                S[0] = d0[j][0] * S[0] + bf_lo(dl[j].x); S[1] = d0[j][1] * S[1] + bf_hi(dl[j].x); S[2] = d0[j][2] * S[2] + bf_lo(dl[j].y); S[3] = d0[j][3] * S[3] + bf_hi(dl[j].y);
                S[4] = d1[j][0] * S[4] + bf_lo(dl[j].z); S[5] = d1[j][1] * S[5] + bf_hi(dl[j].z); S[6] = d1[j][2] * S[6] + bf_lo(dl[j].w); S[7] = d1[j][3] * S[7] + bf_hi(dl[j].w);
            }
        }
    }
}

__device__ void hgrn_c_unit(const Params& p, LAS unsigned char* lds, int bh, int c) {
    const int tid = threadIdx.x, wid = tid >> 6, lane = tid & 63, fr = lane & 15, fq = lane >> 4;
    constexpr int T64 = 64 * LD136, LDA = 144;
    LAS unsigned char* Qt = lds; LAS unsigned char* Kt = lds + T64; LAS unsigned char* Qh = lds + 2 * T64; LAS unsigned char* Is = lds + 3 * T64;
    LAS unsigned char* ST = lds + 4 * T64; LAS unsigned char* ATT = ST + 128 * LD136; LAS float* RS = (LAS float*)(ATT + 64 * LDA); LAS float* SEG = RS + 256;
    const int b = bh >> 3, h = bh & 7, tok0 = b * SEQ + c * 64;
#pragma unroll
    for (int i = 0; i < 2; ++i) {
        const int idx = tid + 512 * i, s = idx >> 4, c8 = (idx & 15) * 8;
        *(LAS u32x4*)(Is + s * LD136 + c8 * 2) = __builtin_nontemporal_load((const u32x4*)(p.QIO() + (size_t)(tok0 + s) * 3072 + 1024 + h * 128 + c8));
    }
    {
        const bf16_t* sp = p.DS() + (size_t)(bh * 32 + c) * 16384;
#pragma unroll
        for (int i = 0; i < 4; ++i) {
            const int idx = tid + 512 * i, vv = idx >> 4, k8 = (idx & 15) * 8;
            *(LAS u32x4*)(ST + vv * LD136 + k8 * 2) = __builtin_nontemporal_load((const u32x4*)(sp + vv * 128 + k8));
        }
    }
    u32x2 ogr[2][2]; f32x4 ngr[2];
    {
        const int t0e = (wid >> 2) * 32, v0e = (wid & 3) * 32;
#pragma unroll
        for (int n = 0; n < 2; ++n) {
            const int ch = h * 128 + v0e + n * 16 + 4 * fq; ngr[n] = *(const f32x4*)(p.hg_norm_g + ch);
#pragma unroll
            for (int m = 0; m < 2; ++m) ogr[m][n] = __builtin_nontemporal_load((const u32x2*)(p.QIO() + (size_t)(tok0 + t0e + m * 16 + fr) * 3072 + 2048 + ch));
        }
    }
    const int k = tid & 127, seg = tid >> 7;
    float v[16], kk[16], qq[16];
#pragma unroll
    for (int i = 0; i < 16; ++i) {
        const size_t tok = (size_t)(tok0 + seg * 16 + i);
        v[i] = __builtin_nontemporal_load(p.LF() + tok * 1024 + h * 128 + k); kk[i] = 1.0f - __expf(v[i]); qq[i] = bf2f(__builtin_nontemporal_load(p.QIO() + tok * 3072 + h * 128 + k));
    }
#pragma unroll
    for (int i = 1; i < 16; ++i) v[i] += v[i - 1];
    SEG[seg * 128 + k] = v[15];
    __syncthreads();
    float off = 0.f;
#pragma unroll
    for (int s = 0; s < 4; ++s) { const float sv = SEG[s * 128 + k]; if (s < seg) off += sv; }
    const float mid = SEG[k] + SEG[128 + k];
#pragma unroll
    for (int i = 0; i < 16; ++i) {
        const float bb = v[i] + off; const int ro = (seg * 16 + i) * LD136 + k * 2;
        *(LAS bf16_t*)(Qt + ro) = f2bf(qq[i] * __expf(fminf(bb - mid, 80.f)));
        *(LAS bf16_t*)(Kt + ro) = f2bf(kk[i] * __expf(fminf(mid - bb, 80.f)));
        *(LAS bf16_t*)(Qh + ro) = f2bf(qq[i] * __expf(bb));
    }
    __syncthreads();
    {
        const int t0 = (wid >> 2) * 32, s0 = (wid & 3) * 16;
        f32x4 a2[2]; a2[0] = (f32x4){0.f, 0.f, 0.f, 0.f}; a2[1] = a2[0];
#pragma unroll
        for (int ks = 0; ks < 4; ++ks) {
            const bf16x8 fn = frag_row(Kt, LD136, s0, ks * 32, fr, fq);
#pragma unroll
            for (int m = 0; m < 2; ++m) a2[m] = mma(fn, frag_row(Qt, LD136, t0 + m * 16, ks * 32, fr, fq), a2[m]);
        }
#pragma unroll
        for (int m = 0; m < 2; ++m) {
            const int t = t0 + m * 16 + fr, s = s0 + 4 * fq; f32x4 a = a2[m];
#pragma unroll
            for (int j = 0; j < 4; ++j) a[j] = (s + j <= t) ? a[j] : 0.f;
            u32x2 o; o.x = cvt_pk_bf16(a[0], a[1]); o.y = cvt_pk_bf16(a[2], a[3]);
            *(LAS u32x2*)(ATT + t * LDA + s * 2) = o;
        }
    }
    __syncthreads();
    const int t0 = (wid >> 2) * 32, v0 = (wid & 3) * 32, wc = wid & 3;
    f32x4 acc[2][2];
#pragma unroll
    for (int m = 0; m < 2; ++m) { acc[m][0] = (f32x4){0.f, 0.f, 0.f, 0.f}; acc[m][1] = acc[m][0]; }
#pragma unroll
    for (int ks = 0; ks < 4; ++ks) {
        bf16x8 fn[2], fm[2];
#pragma unroll
        for (int n = 0; n < 2; ++n) fn[n] = frag_row(ST, LD136, v0 + n * 16, ks * 32, fr, fq);
#pragma unroll
        for (int m = 0; m < 2; ++m) fm[m] = frag_row(Qh, LD136, t0 + m * 16, ks * 32, fr, fq);
#pragma unroll
        for (int m = 0; m < 2; ++m)
#pragma unroll
            for (int n = 0; n < 2; ++n) acc[m][n] = mma(fn[n], fm[m], acc[m][n]);
    }
#pragma unroll
    for (int ks = 0; ks < 2; ++ks) {
        bf16x8 fn[2], fm[2];
#pragma unroll
        for (int n = 0; n < 2; ++n) fn[n] = frag_tr(Is, LD136, v0 + n * 16, ks * 32, fr, fq);
#pragma unroll
        for (int m = 0; m < 2; ++m) fm[m] = frag_row(ATT, LDA, t0 + m * 16, ks * 32, fr, fq);
#pragma unroll
        for (int m = 0; m < 2; ++m)
#pragma unroll
            for (int n = 0; n < 2; ++n) acc[m][n] = mma(fn[n], fm[m], acc[m][n]);
    }
#pragma unroll
    for (int m = 0; m < 2; ++m) {
        float ss = 0.f;
#pragma unroll
        for (int n = 0; n < 2; ++n) { const f32x4 a = acc[m][n]; ss += (a[0] * a[0] + a[1] * a[1]) + (a[2] * a[2] + a[3] * a[3]); }
        ss += __shfl_xor(ss, 16); ss += __shfl_xor(ss, 32);
        if (fq == 0) RS[(t0 + m * 16 + fr) * 4 + wc] = ss;
    }
    __syncthreads();
#pragma unroll
    for (int m = 0; m < 2; ++m) {
        const int t = t0 + m * 16 + fr; const f32x4 rs4 = *(const LAS f32x4*)(RS + t * 4);
        const float r = rsqrtf(((rs4[0] + rs4[1]) + (rs4[2] + rs4[3])) * (1.0f / 128.0f) + EPSF); const size_t tok = (size_t)(tok0 + t);
#pragma unroll
        for (int n = 0; n < 2; ++n) {
            const int ch = h * 128 + v0 + n * 16 + 4 * fq;
            const f32x4 ng = ngr[n]; const u32x2 og = ogr[m][n]; const f32x4 a = acc[m][n];
            u32x2 w; w.x = cvt_pk_bf16(a[0] * r * ng[0] * bf_lo(og.x), a[1] * r * ng[1] * bf_hi(og.x)); w.y = cvt_pk_bf16(a[2] * r * ng[2] * bf_lo(og.y), a[3] * r * ng[3] * bf_hi(og.y));
            *(u32x2*)(p.YB() + tok * 1024 + ch) = w;
        }
    }
    __syncthreads();
}


__device__ __forceinline__ void gsync(cg::grid_group& grid) {
    asm volatile("s_waitcnt vmcnt(0) lgkmcnt(0)" ::: "memory");
    grid.sync();
    asm volatile("s_waitcnt vmcnt(0)" ::: "memory");
    __syncthreads();
}

#define PHASE(i) if (lo <= (i) && (i) < hi) { if ((i) > lo) xcd_barrier(xb);
#define PHASE_END }
__global__ void __launch_bounds__(512, 2) fwd_megakernel(Params p, int lo, int hi) {
    extern __shared__ __attribute__((aligned(16))) unsigned char shm[];
    LAS unsigned char* lds = (LAS unsigned char*)shm;
    cg::grid_group grid = cg::this_grid();
    const int G = (int)gridDim.x, c = (int)blockIdx.x;
    volatile LAS unsigned* xst = (volatile LAS unsigned*)(lds + XST_OFF);
    if (threadIdx.x < 4) xst[threadIdx.x] = 0u;
    __syncthreads();
    const XcdBarrier xb = xcd_barrier_post(p.BAR(), xst);
    if (hi > 4096) gsync(grid);

    PHASE(0) phase0(p, lds); PHASE_END
    if (lo <= 1 && 1 < hi) {
        if (1 > lo) {
            if (threadIdx.x == 0) {
                const unsigned need = (unsigned)min(G, (3072 * KSPLIT + 511) / 512);
                XB_SPIN(xb_ld(p.BAR() + GEMV_CNT) < need, p.BAR());
                __builtin_amdgcn_fence(__ATOMIC_ACQUIRE, "agent");
                asm volatile("s_waitcnt vmcnt(0)" ::: "memory");
            }
            __syncthreads();
        }
        phase_norm(p, lds, 0);
    }
    PHASE(2) {
        StaticOrder S; S.init(NTOK, INW, G, c);
        EpiIn E{p.UV(), p.QIO(), p.GAB(), p.LF(), p.STAT(), p.b_gate, p.hg_lb};
        gemm_phase(lds, Gemm{p.H(), p.WinT(), NTOK, INW, DM, nullptr, nullptr}, S, E);
    } PHASE_END
    constexpr int NFI = TT4 - TT3, NFI_A = NFI / 2;
    PHASE(3) {
        LAS unsigned* tlb = (LAS unsigned*)(lds + 73728);
        int j = 0;
        for (int u = c; u < 512 + 1024; u += G, ++j) {
            const int slot = j * G + c; const bool tv = slot < NFI_A;
            TDesc td; TileRegs tr;
            if (tv) { tdesc(p, TT3 + slot, td); tile_load(td, tr); }
            if (u < 512) gmlp_unit(p, lds, u >> 3, u & 7);
            else hgrn_a_unit(p, lds, (u - 512) >> 5, (u - 512) & 31);
            if (tv) { tile_to_lds(tlb, tr); __syncthreads(); tile_store(tlb, td); }
        }
        transpose_tiles(p, lds, c, G, TT3 + j * G, TT3 + NFI_A);
    } PHASE_END
    PHASE(4) hgrn_scan(p); PHASE_END
    PHASE(5) {
        LAS unsigned* tlb = (LAS unsigned*)(lds + TLB5_OFF);
        constexpr int NS5 = (NFI - NFI_A) + (TT3 - TT2);
        int j = 0;
        for (int u = c; u < 1024; u += G, ++j) {
            const int slot = j * G + c; const bool tv = slot < NS5;
            const int tix = slot < (NFI - NFI_A) ? TT3 + NFI_A + slot : TT2 + (slot - (NFI - NFI_A));
            TDesc td; TileRegs tr;
            if (tv) { tdesc(p, tix, td); tile_load(td, tr); }
            hgrn_c_unit(p, lds, u >> 5, u & 31);
            if (tv) { tile_to_lds(tlb, tr); __syncthreads(); tile_store(tlb, td); }
        }
        for (int slot = j * G + c; slot < NS5; slot += G) {
            const int tix = slot < (NFI - NFI_A) ? TT3 + NFI_A + slot : TT2 + (slot - (NFI - NFI_A));
            transpose_tiles(p, lds, 0, 1, tix, tix + 1);
        }
    } PHASE_END
    PHASE(6) {
        PairOrder S; S.init(NTOK, DM, G, c);
        EpiBrPair E{p.GAB(), p.Y(), (G == (NTOK / BM) * (DM / BM)) ? p.BAR() + 10240 : nullptr, p.BAR()};
        gemm_phase(lds, Gemm{p.YA(), p.WaT(), NTOK, DM, 1024, p.YB(), p.WbT()}, S, E);
    } PHASE_END
    const bool fuse = (G == (NTOK / BM) * (DM / BM));
    if (lo <= 7 && 7 < hi) { if (7 > lo && !fuse) xcd_barrier(xb); {
        StaticOrder S; S.init(NTOK, DM, G, c);
        if (fuse) {
            EpiResNorm<false> E{p.x, p.out, p.MOD() + 2 * 2048, p.norm2_g, p.MOD() + 3 * 2048, p.MOD() + 4 * 2048, p.H(), p.STAT(), p.BAR() + 3584, p.BAR(), p.BAR() + 8192};
            gemm_phase(lds, Gemm{p.Y(), p.WoutT(), NTOK, DM, DM, nullptr, nullptr}, S, E);
        } else {
            EpiRes E{p.x, p.out, p.MOD() + 2 * 2048};
            gemm_phase(lds, Gemm{p.Y(), p.WoutT(), NTOK, DM, DM, nullptr, nullptr}, S, E);
        }
    } PHASE_END
    if (!fuse) { PHASE(8) phase_norm(p, lds, 1); PHASE_END }
    if (lo <= 9 && 9 < hi) { if (9 > lo && !fuse) xcd_barrier(xb); {
        StaticOrder S; S.init(NTOK, 2 * FH, G, c);
        EpiSwi E{p.ACT()};
        gemm_phase(lds, Gemm{p.H(), p.WfiT(), NTOK, 2 * FH, DM, nullptr, nullptr}, S, E);
        {
            const int rounds = (S.nwg + G - 1) / G, busy = S.nwg - (rounds - 1) * G;
            if (busy < G) { if (c >= busy) transpose_tiles(p, lds, c - busy, G - busy, TT4, TT5); }
            else transpose_tiles(p, lds, c, G, TT4, TT5);
        }
    } PHASE_END
    PHASE(10) {
        StaticOrder S; S.init(NTOK, DM, G, c);
        if (fuse) {
            EpiResNorm<true> E{p.out, p.out, p.MOD() + 5 * 2048, p.final_g, nullptr, nullptr, nullptr, p.STAT(), p.BAR() + 5632, p.BAR(), nullptr};
            gemm_phase(lds, Gemm{p.ACT(), p.WfoT(), NTOK, DM, FH, nullptr, nullptr}, S, E);
        } else {
            EpiRes E{p.out, p.out, p.MOD() + 5 * 2048};
            gemm_phase(lds, Gemm{p.ACT(), p.WfoT(), NTOK, DM, FH, nullptr, nullptr}, S, E);
        }
    } PHASE_END
    if (!fuse) { PHASE(11) phase_norm(p, lds, 2); PHASE_END }
}


extern "C" void kernel_launch(void* const* d_in, const int* in_sizes, int n_in, void* d_out, int out_size, void* d_ws, size_t ws_size, hipStream_t stream) {
    constexpr size_t kDynLds = DYN_LDS;
    static int grid_blocks = 0;
    if (!grid_blocks) {
        int dev = 0, cus = 0, per_cu = 0;
        hipGetDevice(&dev);
        hipDeviceGetAttribute(&cus, hipDeviceAttributeMultiprocessorCount, dev);
        hipFuncSetAttribute((const void*)fwd_megakernel, hipFuncAttributeMaxDynamicSharedMemorySize, (int)kDynLds);
        hipOccupancyMaxActiveBlocksPerMultiprocessor(&per_cu, fwd_megakernel, 512, kDynLds);
        if (per_cu < 1) per_cu = 1;
        grid_blocks = cus * per_cu;
        if (grid_blocks > 256) grid_blocks = 256;
    }
    Params p{};
    const float* const* in = (const float* const*)d_in;
    p.x = in[0]; p.c = in[1]; p.w_ada = in[2]; p.b_ada = in[3]; p.norm1_g = in[4]; p.w_in = in[5]; p.b_gate = in[6]; p.ln_g = in[7]; p.ln_b = in[8];
    p.gws = in[9]; p.gbs = in[10]; p.hg_lb = in[11]; p.hg_norm_g = in[12]; p.w_bg = in[13]; p.w_bh = in[14]; p.w_out = in[15]; p.norm2_g = in[16];
    p.w_ffn_in = in[17]; p.w_ffn_out = in[18]; p.final_g = in[19];
    p.out = (float*)d_out;
    p.ws = (char*)d_ws;
    if (ws_size < WS_TOTAL) fprintf(stderr, "workspace too small: %zu < %zu\n", ws_size, (size_t)WS_TOTAL);
    hipMemsetAsync((char*)d_ws + OFF_BAR, 0, (size_t)16384 * 4, stream);
    int lo = 0, hi = 12;
    void* args[] = {&p, &lo, &hi};
    hipError_t e = hipLaunchCooperativeKernel((void*)fwd_megakernel, dim3(grid_blocks), dim3(512), args, kDynLds, stream);
    if (e != hipSuccess) fprintf(stderr, "cooperative launch failed: %s (grid %d)\n", hipGetErrorString(e), grid_blocks);
}
```

```cpp
#include <hip/hip_runtime.h>
#include <hip/hip_cooperative_groups.h>
#include <cstdio>
namespace cg = cooperative_groups;

#define LAS __attribute__((address_space(3)))
typedef unsigned short bf16_t;
typedef short bf16x8 __attribute__((ext_vector_type(8)));
typedef short s16x4 __attribute__((ext_vector_type(4)));
typedef float f32x4 __attribute__((ext_vector_type(4)));
typedef float f32x2 __attribute__((ext_vector_type(2)));
typedef unsigned u32x4 __attribute__((ext_vector_type(4)));
typedef unsigned u32x2 __attribute__((ext_vector_type(2)));

constexpr int DM = 2048, NB = 4, SEQ = 2048, NTOK = NB * SEQ, INW = 10240, FH = 5632;
constexpr int BM = 256, BK = 64, HALF = 128, HTB = HALF * BK * 2, STAGE_BYTES = 8 * HTB, NXCD = 8, WGM = 8;
constexpr int KSPLIT = 32;
constexpr int GEMV_CNT = 7744;
constexpr int TLB5_OFF = 117760, XST_OFF = TLB5_OFF + 128 * 65 * 4, DYN_LDS = XST_OFF + 16;
constexpr float EPSF = 1e-6f;

constexpr size_t al256(size_t b) { return (b + 255) & ~(size_t)255; }
constexpr size_t OFF_WAT = 0;
constexpr size_t OFF_WBT = OFF_WAT + al256((size_t)2048 * 1024 * 2);
constexpr size_t OFF_WOUT = OFF_WBT + al256((size_t)2048 * 1024 * 2);
constexpr size_t OFF_WFI = OFF_WOUT + al256((size_t)2048 * 2048 * 2);
constexpr size_t OFF_WFO = OFF_WFI + al256((size_t)2 * FH * 2048 * 2);
constexpr size_t OFF_R1 = OFF_WFO + al256((size_t)2048 * FH * 2);
constexpr size_t OFF_H = OFF_R1 + (size_t)INW * 2048 * 2;
constexpr size_t OFF_UV = OFF_R1 + al256((size_t)INW * 2048 * 2 + (size_t)NTOK * 2048 * 2);
constexpr size_t OFF_R2 = OFF_UV + al256((size_t)NTOK * 2048 * 2);
constexpr size_t OFF_LF = OFF_R2 + (size_t)NTOK * 3072 * 2;
constexpr size_t OFF_GAB = OFF_LF + (size_t)NTOK * 1024 * 4;
constexpr size_t OFF_YA = OFF_R2 + al256((size_t)NTOK * 3072 * 2 + (size_t)NTOK * 1024 * 4 + (size_t)NTOK * 4096 * 2);
constexpr size_t OFF_YB = OFF_YA + al256((size_t)NTOK * 1024 * 2);
constexpr size_t OFF_DV = OFF_YB + al256((size_t)NTOK * 1024 * 2);
constexpr size_t OFF_PART = OFF_DV + al256((size_t)1024 * 128 * 4);
constexpr size_t OFF_MOD = OFF_PART + al256((size_t)KSPLIT * 4 * 12288 * 4);
constexpr size_t OFF_STAT = OFF_MOD + al256((size_t)4 * 12288 * 4);
constexpr size_t OFF_BAR = OFF_STAT + al256((size_t)NTOK * 32 * 4);
constexpr size_t WS_TOTAL = OFF_BAR + al256((size_t)16384 * 4);

struct Params {
    const float *x, *c, *w_ada, *b_ada, *norm1_g, *w_in, *b_gate, *ln_g, *ln_b, *gws, *gbs, *hg_lb, *hg_norm_g,
        *w_bg, *w_bh, *w_out, *norm2_g, *w_ffn_in, *w_ffn_out, *final_g;
    float* out;
    char* ws;
#define WSP(T, name, off) __device__ __forceinline__ T* name() const { return (T*)(ws + (off)); }
    WSP(bf16_t, WaT, OFF_WAT) WSP(bf16_t, WbT, OFF_WBT) WSP(bf16_t, WoutT, OFF_WOUT) WSP(bf16_t, WfiT, OFF_WFI) WSP(bf16_t, WfoT, OFF_WFO)
    WSP(bf16_t, WinT, OFF_R1) WSP(bf16_t, H, OFF_H) WSP(bf16_t, DS, OFF_R1) WSP(float, TB, OFF_R1)
    WSP(bf16_t, UV, OFF_UV) WSP(bf16_t, Y, OFF_UV)
    WSP(bf16_t, QIO, OFF_R2) WSP(float, LF, OFF_LF) WSP(bf16_t, GAB, OFF_GAB) WSP(bf16_t, ACT, OFF_R2)
    WSP(bf16_t, YA, OFF_YA) WSP(bf16_t, YB, OFF_YB) WSP(float, DV, OFF_DV) WSP(float, PART, OFF_PART) WSP(float, MOD, OFF_MOD) WSP(float, STAT, OFF_STAT) WSP(unsigned, BAR, OFF_BAR)
#undef WSP
};

typedef __bf16 bf16v2 __attribute__((ext_vector_type(2)));
__device__ __forceinline__ unsigned cvt_pk_bf16(float lo, float hi) { const f32x2 v = {lo, hi}; return __builtin_bit_cast(unsigned, __builtin_convertvector(v, bf16v2)); }
__device__ __forceinline__ float bf_lo(unsigned w) { return __uint_as_float(w << 16); }
__device__ __forceinline__ float bf_hi(unsigned w) { return __uint_as_float(w & 0xffff0000u); }
__device__ __forceinline__ float bf2f(bf16_t v) { return __uint_as_float(((unsigned)v) << 16); }
__device__ __forceinline__ bf16_t f2bf(float f) { return (bf16_t)(cvt_pk_bf16(f, 0.f) & 0xffffu); }
__device__ __forceinline__ float sigmoidf_(float x) { return __builtin_amdgcn_rcpf(1.0f + __expf(-x)); }
__device__ __forceinline__ float siluf_(float x) { return x * sigmoidf_(x); }
__device__ __forceinline__ float geluf_(float x) { const float y = 1.5957691216f * (x + 0.044715f * x * x * x); return x * sigmoidf_(y); }

__device__ __forceinline__ int lds_byte(int r, int c) { const int st = (r >> 4) * 2 + (c >> 5), rr = r & 15, cc = c & 31, ob = rr * 64 + cc * 2; return st * 1024 + (ob ^ (((ob >> 9) & 1) << 5)); }
__device__ __forceinline__ int perm32(int rho) { const int n = rho >> 4, i = rho & 15; return 8 * (i >> 2) + 4 * n + (i & 3); }
__device__ __forceinline__ void stage_rc(int b, int& R, int& C) { const int st = b / 1024, sb = b % 1024, swz = sb ^ (((sb >> 9) & 1) << 5); R = (st >> 1) * 16 + swz / 64; C = (st & 1) * 32 + (swz % 64) / 2; }

struct Unit { int pm, pn, sel; };
struct Gemm { const bf16_t* A; const bf16_t* Bt; int M, N, K; const bf16_t* A2; const bf16_t* Bt2; };
struct StaticOrder {
    int nM, nN, nwg, G, c;
    __device__ void init(int M, int N, int G_, int c_) { nM = M / BM; nN = N / BM; nwg = nM * nN; G = G_; c = c_; }
    __device__ bool next(int i, Unit& u) const {
        const long L = (long)i * G + c; if (L >= nwg) return false;
        int wgid = (int)L; { const int q = nwg / NXCD, r = nwg % NXCD, xcd = wgid % NXCD, off = wgid / NXCD; wgid = (xcd < r ? xcd * (q + 1) : r * (q + 1) + (xcd - r) * q) + off; }
        const int nig = WGM * nN, gid = wgid / nig, fm = gid * WGM, gsz = (nM - fm) < WGM ? (nM - fm) : WGM;
        u.pm = fm + ((wgid % nig) % gsz); u.pn = (wgid % nig) / gsz; u.sel = 0; return true;
    }
};
struct PairOrder {
    StaticOrder S; int nwg;
    __device__ void init(int M, int N, int G_, int c_) { S.init(M, N, G_, c_); nwg = S.nwg; }
    __device__ bool next(int i, Unit& u) const { if (!S.next(i >> 1, u)) return false; u.sel = i & 1; return true; }
};

#ifndef K_SP2
#define K_SP2 true
#endif
#ifndef K_ALIGN
#define K_ALIGN false
#endif
template <class Epi, class Sched>
__device__ __forceinline__ void gemm_phase(LAS unsigned char* lds, const Gemm g, const Sched& S, const Epi& E) {
    constexpr bool SP2 = K_SP2, ALIGN_EPI = Epi::ALIGN && !Epi::AFTER_DRAIN;
    const int tid = threadIdx.x, wid = __builtin_amdgcn_readfirstlane(tid >> 6), lane = tid & 63, wr = wid >> 2, wc = wid & 3, fr = lane & 15, fq = lane >> 4;
    const int K = g.K, nt = K / BK;
    unsigned voffA[2], voffB[2];
#pragma unroll
    for (int i = 0; i < 2; ++i) { int R, C; stage_rc(tid * 16 + i * 8192, R, C); const int Rb = Epi::PERM ? ((R & ~31) + perm32(R & 31)) : R; voffA[i] = (unsigned)(R * K + C) * 2u; voffB[i] = (unsigned)(Rb * K + C) * 2u; }
    const size_t kstep = (size_t)(BK * 2);
    const size_t hstep = (size_t)HALF * K * 2;
    const size_t tstep = 2 * hstep;
    const unsigned ldsw = (unsigned)wid * 1024u;
    const int aoff = lds_byte(wr * 64 + fr, fq * 8), boff = lds_byte(wc * 32 + fr, fq * 8);
#define PG8_SA(b, h) (((b) * 2 + (h)) * HTB)
#define PG8_SB(b, h) ((4 + (b) * 2 + (h)) * HTB)
#define PG8_STAGE(bufoff, gbase, voff) do { _Pragma("unroll") for (int _i = 0; _i < 2; ++_i) \
        __builtin_amdgcn_global_load_lds((const unsigned*)((const char*)(gbase) + (voff)[_i]), (LAS unsigned*)(lds + (bufoff) + ldsw + _i * 8192), 16, 0, 0); } while (0)
#define PG8_LDA(dst, b, h) do { _Pragma("unroll") for (int m = 0; m < 4; ++m) _Pragma("unroll") for (int k = 0; k < 2; ++k) dst[m][k] = *(const LAS bf16x8*)(lds + PG8_SA(b, h) + aoff + m * 2048 + k * 1024); } while (0)
#define PG8_LDB(dst, b, h) do { _Pragma("unroll") for (int n = 0; n < 2; ++n) _Pragma("unroll") for (int k = 0; k < 2; ++k) dst[n][k] = *(const LAS bf16x8*)(lds + PG8_SB(b, h) + boff + n * 2048 + k * 1024); } while (0)
#define PG8_MMA(ai, bj, At, Bt) do { __builtin_amdgcn_s_setprio(1); _Pragma("unroll") for (int m = 0; m < 4; ++m) _Pragma("unroll") for (int n = 0; n < 2; ++n) _Pragma("unroll") for (int k = 0; k < 2; ++k) \
        acc[ai][bj][m][n] = __builtin_amdgcn_mfma_f32_16x16x32_bf16(Bt[n][k], At[m][k], acc[ai][bj][m][n], 0, 0, 0); __builtin_amdgcn_s_setprio(0); } while (0)
#define PG8_WAIT_V(n) asm volatile("s_waitcnt vmcnt(" #n ")" ::: "memory")
#define PG8_WAIT_L(n) asm volatile("s_waitcnt lgkmcnt(" #n ")" ::: "memory")
#define PG8_BAR __builtin_amdgcn_s_barrier()
#define PG8_SCHED __builtin_amdgcn_sched_barrier(0)
    Unit cur, nxt; int ui = 0;
    if (!S.next(0, cur)) return;
    f32x4 acc[2][2][4][2];
#pragma unroll
    for (int a = 0; a < 2; ++a)
#pragma unroll
        for (int b = 0; b < 2; ++b)
#pragma unroll
            for (int m = 0; m < 4; ++m)
#pragma unroll
                for (int n = 0; n < 2; ++n) acc[a][b][m][n] = (f32x4){0.f, 0.f, 0.f, 0.f};
    bf16x8 At[4][2], B0[2][2], B1[2][2];
    const char* cA = (const char*)((Epi::PAIR && cur.sel) ? g.A2 : g.A) + (size_t)cur.pm * tstep; const char* cB = (const char*)((Epi::PAIR && cur.sel) ? g.Bt2 : g.Bt) + (size_t)cur.pn * tstep;
    if constexpr (SP2) {
        PG8_STAGE(PG8_SB(0, 0), cB, voffB); PG8_STAGE(PG8_SB(0, 1), cB + hstep, voffB); PG8_STAGE(PG8_SA(0, 0), cA, voffA); PG8_STAGE(PG8_SA(0, 1), cA + hstep, voffA);
        if (wr == 1) PG8_BAR;
        PG8_WAIT_V(2); PG8_BAR;
        PG8_STAGE(PG8_SB(1, 0), cB + kstep, voffB); PG8_STAGE(PG8_SA(1, 0), cA + kstep, voffA); PG8_STAGE(PG8_SB(1, 1), cB + hstep + kstep, voffB);
        PG8_WAIT_V(6); PG8_BAR;
    } else {
        PG8_STAGE(PG8_SB(0, 0), cB, voffB); PG8_STAGE(PG8_SA(0, 0), cA, voffA); PG8_STAGE(PG8_SB(0, 1), cB + hstep, voffB); PG8_STAGE(PG8_SA(0, 1), cA + hstep, voffA);
        if (wr == 1) PG8_BAR;
        PG8_WAIT_V(4); PG8_BAR;
        PG8_STAGE(PG8_SB(1, 0), cB + kstep, voffB); PG8_STAGE(PG8_SA(1, 0), cA + kstep, voffA); PG8_STAGE(PG8_SB(1, 1), cB + hstep + kstep, voffB);
        PG8_WAIT_V(6); PG8_BAR;
    }
    for (;;) {
        const bool has_next = S.next(ui + 1, nxt);
        const char* nA = has_next ? (const char*)((Epi::PAIR && nxt.sel) ? g.A2 : g.A) + (size_t)nxt.pm * tstep : cA; const char* nB = has_next ? (const char*)((Epi::PAIR && nxt.sel) ? g.Bt2 : g.Bt) + (size_t)nxt.pn * tstep : cB;
        for (int t = 0; t < nt; t += 2) {
            const bool last = (t == nt - 2);
            const char* a1 = cA + (size_t)(t + 1) * kstep;
            const char* a2 = last ? nA : cA + (size_t)(t + 2) * kstep; const char* b2 = last ? nB : cB + (size_t)(t + 2) * kstep;
            const char* a3 = a2 + kstep; const char* b3 = b2 + kstep;
            if constexpr (SP2) {
            PG8_LDB(B0, 0, 0); PG8_LDB(B1, 0, 1); PG8_SCHED; PG8_LDA(At, 0, 0); PG8_STAGE(PG8_SA(1, 1), a1 + hstep, voffA);
            PG8_WAIT_V(8); PG8_WAIT_L(0); PG8_BAR; PG8_MMA(0, 0, At, B0); PG8_MMA(0, 1, At, B1); PG8_BAR; PG8_SCHED;
            PG8_LDA(At, 0, 1); PG8_STAGE(PG8_SB(0, 0), b2, voffB); PG8_STAGE(PG8_SB(0, 1), b2 + hstep, voffB); PG8_STAGE(PG8_SA(0, 0), a2, voffA);
            PG8_WAIT_V(8); PG8_WAIT_L(0); PG8_BAR; PG8_MMA(1, 0, At, B0); PG8_MMA(1, 1, At, B1); PG8_BAR; PG8_SCHED;
            PG8_LDB(B0, 1, 0); PG8_LDB(B1, 1, 1); PG8_SCHED; PG8_LDA(At, 1, 0); PG8_STAGE(PG8_SA(0, 1), a2 + hstep, voffA);
            PG8_WAIT_V(8); PG8_WAIT_L(0); PG8_BAR; PG8_MMA(0, 0, At, B0); PG8_MMA(0, 1, At, B1); PG8_BAR; PG8_SCHED;
            PG8_LDA(At, 1, 1); PG8_STAGE(PG8_SB(1, 0), b3, voffB); PG8_STAGE(PG8_SB(1, 1), b3 + hstep, voffB); PG8_STAGE(PG8_SA(1, 0), a3, voffA);
            PG8_WAIT_V(8); PG8_WAIT_L(0); PG8_BAR; PG8_MMA(1, 0, At, B0); PG8_MMA(1, 1, At, B1); PG8_BAR; PG8_SCHED;
            } else {
            PG8_LDB(B0, 0, 0); PG8_SCHED; PG8_LDA(At, 0, 0); PG8_STAGE(PG8_SA(1, 1), a1 + hstep, voffA);
            PG8_WAIT_L(8); PG8_BAR; PG8_WAIT_L(0); PG8_MMA(0, 0, At, B0); PG8_BAR; PG8_SCHED;
            PG8_LDB(B1, 0, 1); PG8_STAGE(PG8_SB(0, 0), b2, voffB);
            PG8_BAR; PG8_WAIT_L(0); PG8_MMA(0, 1, At, B1); PG8_BAR;
            PG8_LDA(At, 0, 1); PG8_STAGE(PG8_SA(0, 0), a2, voffA);
            PG8_BAR; PG8_WAIT_L(0); PG8_MMA(1, 0, At, B0); PG8_BAR; PG8_SCHED;
            PG8_STAGE(PG8_SB(0, 1), b2 + hstep, voffB);
            PG8_WAIT_V(6); PG8_BAR; PG8_MMA(1, 1, At, B1); PG8_BAR;
            PG8_LDB(B0, 1, 0); PG8_SCHED; PG8_LDA(At, 1, 0); PG8_STAGE(PG8_SA(0, 1), a2 + hstep, voffA);
            PG8_WAIT_L(8); PG8_BAR; PG8_WAIT_L(0); PG8_MMA(0, 0, At, B0); PG8_BAR; PG8_SCHED;
            PG8_LDB(B1, 1, 1); PG8_STAGE(PG8_SB(1, 0), b3, voffB);
            PG8_BAR; PG8_WAIT_L(0); PG8_MMA(0, 1, At, B1); PG8_BAR;
            PG8_LDA(At, 1, 1); PG8_STAGE(PG8_SA(1, 0), a3, voffA);
            PG8_BAR; PG8_WAIT_L(0); PG8_MMA(1, 0, At, B0); PG8_BAR; PG8_SCHED;
            PG8_STAGE(PG8_SB(1, 1), b3 + hstep, voffB);
            PG8_WAIT_V(6); PG8_BAR; PG8_MMA(1, 1, At, B1); PG8_BAR;
            }
        }
        if constexpr (ALIGN_EPI) { if (wr == 0) PG8_BAR; }
        if constexpr (!Epi::AFTER_DRAIN) E(acc, cur, wr, wc, fr, fq);
        if (!has_next) break;
        if (!(Epi::PAIR && nxt.sel == 1))
#pragma unroll
        for (int a = 0; a < 2; ++a)
#pragma unroll
            for (int b = 0; b < 2; ++b)
#pragma unroll
                for (int m = 0; m < 4; ++m)
#pragma unroll
                    for (int n = 0; n < 2; ++n) acc[a][b][m][n] = (f32x4){0.f, 0.f, 0.f, 0.f};
        cur = nxt; cA = nA; cB = nB; ++ui;
        if constexpr (ALIGN_EPI) { if (wr == 1) PG8_BAR; }
    }
    PG8_WAIT_V(0);
    if constexpr (!ALIGN_EPI) { if (wr == 0) PG8_BAR; }
    PG8_BAR;
    if constexpr (Epi::AFTER_DRAIN) E.fused(acc, cur, wr, wc, fr, fq, lds);
#undef PG8_SA
#undef PG8_SB
#undef PG8_STAGE
#undef PG8_LDA
#undef PG8_LDB
#undef PG8_MMA
#undef PG8_WAIT_V
#undef PG8_WAIT_L
#undef PG8_BAR
#undef PG8_SCHED
}

#define XB_TMO      128
#define XB_XCNT(j)  (256  + 64 * (j))
#define XB_XSUB(j)  (1280 + 64 * (j))
#define XB_XGEN(j)  (2304 + 64 * (j))
#define XB_TOP      3328
#define XB_TOPGEN   3392
#define XCD_BAR_WORDS 3456
#define XB_SPIN_CAP (1u << 18)
__device__ __forceinline__ unsigned xb_ld(unsigned* p)              { return __hip_atomic_load(p, __ATOMIC_RELAXED, __HIP_MEMORY_SCOPE_AGENT); }
__device__ __forceinline__ unsigned xb_add(unsigned* p, unsigned v) { return __hip_atomic_fetch_add(p, v, __ATOMIC_RELAXED, __HIP_MEMORY_SCOPE_AGENT); }
__device__ __forceinline__ unsigned xb_xcc_id() { return (unsigned)__builtin_amdgcn_s_getreg((3 << 11) | 20) & 0xFu; }
#define XB_SPIN(cond, bar) do { unsigned _sp = 0; while (cond) { __builtin_amdgcn_s_sleep(1); \
    if ((++_sp & 255u) == 0u) { if (xb_ld(&(bar)[XB_TMO])) break; if (_sp > XB_SPIN_CAP) { atomicAdd(&(bar)[XB_TMO], 1u); break; } } } } while (0)
struct XcdBarrier { unsigned* bar; unsigned x; volatile LAS unsigned* st; };
__device__ __forceinline__ XcdBarrier xcd_barrier_post(unsigned* bar, volatile LAS unsigned* st) {
    XcdBarrier b; b.bar = bar; b.x = xb_xcc_id(); b.st = st;
    if (threadIdx.x == 0) (void)xb_add(&bar[XB_XCNT(b.x)], 1u);
    return b;
}
__device__ __forceinline__ void xcd_barrier_complete(unsigned* bar, unsigned x, unsigned& nloc, unsigned& nx) {
    const unsigned G = gridDim.x * gridDim.y * gridDim.z;
    unsigned sum, cnt, mine, sp = 0u;
    for (;;) {
        sum = 0u; cnt = 0u; mine = 0u;
#pragma unroll
        for (unsigned j = 0; j < 16; ++j) { const unsigned c = xb_ld(&bar[XB_XCNT(j)]); sum += c; cnt += (c > 0u) ? 1u : 0u; mine = (j == x) ? c : mine; }
        if (sum == G) break;
        __builtin_amdgcn_s_sleep(1);
        if ((++sp & 255u) == 0u) { if (xb_ld(&bar[XB_TMO])) break; if (sp > XB_SPIN_CAP) { atomicAdd(&bar[XB_TMO], 1u); break; } }
    }
    nloc = mine > 0u ? mine : 1u; nx = cnt > 0u ? cnt : 1u;
}
__device__ __forceinline__ void xcd_barrier(const XcdBarrier& b) {
    asm volatile("s_waitcnt vmcnt(0) lgkmcnt(0)" ::: "memory");
    __syncthreads();
    if (threadIdx.x == 0) {
        unsigned* bar = b.bar;
        __builtin_amdgcn_s_waitcnt(0);
        unsigned nloc = b.st[0], nx = b.st[1];
        if (nloc == 0u) { xcd_barrier_complete(bar, b.x, nloc, nx); b.st[0] = nloc; b.st[1] = nx; }
        const unsigned old = xb_add(&bar[XB_XSUB(b.x)], 1u);
        const unsigned gen = old / nloc;
        if (old + 1u == (gen + 1u) * nloc) {
            __builtin_amdgcn_fence(__ATOMIC_RELEASE, "agent");
            asm volatile("s_waitcnt vmcnt(0)" ::: "memory");
            const unsigned og = xb_add(&bar[XB_TOP], 1u);
            const unsigned tg = og / nx;
            if (og + 1u == (tg + 1u) * nx) xb_add(&bar[XB_TOPGEN], 1u);
            else XB_SPIN(xb_ld(&bar[XB_TOPGEN]) == tg, bar);
            __builtin_amdgcn_fence(__ATOMIC_ACQUIRE, "agent");
            xb_add(&bar[XB_XGEN(b.x)], 1u);
            asm volatile("s_waitcnt vmcnt(0)" ::: "memory");
        } else {
            XB_SPIN(xb_ld(&bar[XB_XGEN(b.x)]) == gen, bar);
            __builtin_amdgcn_fence(__ATOMIC_ACQUIRE, "agent");
            asm volatile("s_waitcnt vmcnt(0)" ::: "memory");
        }
    }
    __syncthreads();
}

typedef f32x4 AccT[2][2][4][2];

__device__ __forceinline__ u32x4 pack8(const f32x4 a, const f32x4 b) { u32x4 w; w.x = cvt_pk_bf16(a[0], a[1]); w.y = cvt_pk_bf16(a[2], a[3]); w.z = cvt_pk_bf16(b[0], b[1]); w.w = cvt_pk_bf16(b[2], b[3]); return w; }
__device__ __forceinline__ f32x4 unpk_lo(const u32x4 w) { return (f32x4){bf_lo(w.x), bf_hi(w.x), bf_lo(w.y), bf_hi(w.y)}; }
__device__ __forceinline__ f32x4 unpk_hi(const u32x4 w) { return (f32x4){bf_lo(w.z), bf_hi(w.z), bf_lo(w.w), bf_hi(w.w)}; }
__device__ __forceinline__ f32x4 map4(const f32x4 a, float (*f)(float)) { return (f32x4){f(a[0]), f(a[1]), f(a[2]), f(a[3])}; }
__device__ __forceinline__ f32x4 rcp4(const f32x4 a) { return (f32x4){__builtin_amdgcn_rcpf(a[0]), __builtin_amdgcn_rcpf(a[1]), __builtin_amdgcn_rcpf(a[2]), __builtin_amdgcn_rcpf(a[3])}; }
__device__ __forceinline__ float sum4(const f32x4 a) { return (a[0] + a[1]) + (a[2] + a[3]); }

#ifndef AL_IN
#define AL_IN true
#endif
#ifndef AL_BR
#define AL_BR true
#endif
#ifndef AL_SW
#define AL_SW true
#endif
struct EpiIn {
    static constexpr bool MID = false, AFTER_DRAIN = false, PAIR = false, PERM = true, ALIGN = AL_IN;
    bf16_t *UV, *QIO, *GAB; float *LF, *STAT; const float *b_gate, *hg_lb;
    __device__ __forceinline__ void operator()(const AccT& acc, const Unit& u, int wr, int wc, int fr, int fq) const {
        const int pn = u.pn, row0 = u.pm * BM + wr * 64 + fr, c8 = wc * 32 + 8 * fq, colt = pn * BM;
        if (pn < 8) {
#pragma unroll
            for (int ai = 0; ai < 2; ++ai)
#pragma unroll
                for (int m = 0; m < 4; ++m) {
                    const int row = row0 + ai * HALF + m * 16; float s1 = 0.f, s2 = 0.f;
#pragma unroll
                    for (int bj = 0; bj < 2; ++bj) {
                        const f32x4 v0 = map4(acc[ai][bj][m][0], geluf_), v1 = map4(acc[ai][bj][m][1], geluf_);
                        s1 += sum4(v0) + sum4(v1); s2 += sum4(v0 * v0) + sum4(v1 * v1);
                        *(u32x4*)(UV + (size_t)row * 2048 + colt + bj * HALF + c8) = pack8(v0, v1);
                    }
                    if (pn >= 4) {
                        s1 += __shfl_xor(s1, 16); s1 += __shfl_xor(s1, 32); s2 += __shfl_xor(s2, 16); s2 += __shfl_xor(s2, 32);
                        if (fq == 0) *(f32x2*)(STAT + ((size_t)row * 16 + (pn - 4) * 4 + wc) * 2) = (f32x2){s1, s2};
                    }
                }
        } else if (pn >= 12 && pn < 16) {
            const int cb = colt - 3072;
#pragma unroll
            for (int bj = 0; bj < 2; ++bj) {
                const int col = cb + bj * HALF + c8;
                f32x4 lb[2];
#pragma unroll
                for (int n = 0; n < 2; ++n) { const f32x4 l0 = *(const f32x4*)(hg_lb + col + 4 * n), l1 = *(const f32x4*)(hg_lb + 1024 + col + 4 * n); lb[n] = map4(l0 - l1, sigmoidf_); }
#pragma unroll
                for (int ai = 0; ai < 2; ++ai)
#pragma unroll
                    for (int m = 0; m < 4; ++m) {
                        const int row = row0 + ai * HALF + m * 16;
#pragma unroll
                        for (int n = 0; n < 2; ++n) {
                            const f32x4 sg = map4(acc[ai][bj][m][n], sigmoidf_); const f32x4 f = lb[n] + (1.0f - lb[n]) * sg;
                            *(f32x4*)(LF + (size_t)row * 1024 + col + 4 * n) = (f32x4){__logf(f[0]), __logf(f[1]), __logf(f[2]), __logf(f[3])};
                        }
                    }
            }
        } else if (pn < 24) {
            const int seg = pn >> 2;
            const int cb = (seg == 2) ? colt - 2048 : (seg == 4) ? colt - 4096 + 1024 : colt - 5120 + 2048;
            const bool act = (seg != 4);
#pragma unroll
            for (int ai = 0; ai < 2; ++ai)
#pragma unroll
                for (int m = 0; m < 4; ++m) {
                    const int row = row0 + ai * HALF + m * 16;
#pragma unroll
                    for (int bj = 0; bj < 2; ++bj) {
                        f32x4 a0 = acc[ai][bj][m][0], a1 = acc[ai][bj][m][1];
                        if (act) { a0 = map4(a0, siluf_); a1 = map4(a1, siluf_); }
                        *(u32x4*)(QIO + (size_t)row * 3072 + cb + bj * HALF + c8) = pack8(a0, a1);
                    }
                }
        } else {
            const int cb = colt - 6144;
#pragma unroll
            for (int bj = 0; bj < 2; ++bj) {
                const int col = cb + bj * HALF + c8; const f32x4 bg0 = *(const f32x4*)(b_gate + col), bg1 = *(const f32x4*)(b_gate + col + 4);
#pragma unroll
                for (int ai = 0; ai < 2; ++ai)
#pragma unroll
                    for (int m = 0; m < 4; ++m) {
                        const int row = row0 + ai * HALF + m * 16;
                        *(u32x4*)(GAB + (size_t)row * 4096 + col) = pack8(map4(acc[ai][bj][m][0] + bg0, sigmoidf_), map4(acc[ai][bj][m][1] + bg1, sigmoidf_));
                    }
            }
        }
    }
};

struct EpiBrPair {
    static constexpr bool MID = false, AFTER_DRAIN = false, PAIR = true, PERM = true, ALIGN = AL_BR;
    const bf16_t* GAB; bf16_t* Y; unsigned* cnt3; unsigned* bar;
    __device__ __forceinline__ void operator()(AccT& acc, const Unit& u, int wr, int wc, int fr, int fq) const {
        const int row0 = u.pm * BM + wr * 64 + fr, col0 = u.pn * BM + wc * 32 + 8 * fq;
        const __amdgpu_buffer_rsrc_t rY = __builtin_amdgcn_make_buffer_rsrc((void*)Y, (short)0, (int)((size_t)NTOK * 2048 * 2), 0x00020000);
#pragma unroll
        for (int ai = 0; ai < 2; ++ai)
#pragma unroll
            for (int m = 0; m < 4; ++m) {
                const size_t row = (size_t)(row0 + ai * HALF + m * 16);
#pragma unroll
                for (int bj = 0; bj < 2; ++bj) {
                    const int col = col0 + bj * HALF;
                    const u32x4 b = __builtin_nontemporal_load((const u32x4*)(GAB + row * 4096 + 2048 + col));
                    if (u.sel == 0) {
                        const u32x4 a = __builtin_nontemporal_load((const u32x4*)(GAB + row * 4096 + col));
                        acc[ai][bj][m][0] *= unpk_lo(a) * rcp4(unpk_lo(b)); acc[ai][bj][m][1] *= unpk_hi(a) * rcp4(unpk_hi(b));
                    } else {
                        __builtin_amdgcn_raw_buffer_store_b128(pack8(acc[ai][bj][m][0] * unpk_lo(b), acc[ai][bj][m][1] * unpk_hi(b)), rY, (unsigned)((row * 2048 + col) * 2), 0, 16);
                    }
                }
            }
        if (cnt3 && u.sel == 1) {
            asm volatile("s_waitcnt vmcnt(0)" ::: "memory");
            __syncthreads();
            if (threadIdx.x == 0) {
                unsigned* cw = cnt3 + 64 * u.pm;
                (void)xb_add(cw, 1u);
                XB_SPIN(xb_ld(cw) < 8u, bar);
                __builtin_amdgcn_fence(__ATOMIC_ACQUIRE, "agent");
                asm volatile("s_waitcnt vmcnt(0)" ::: "memory");
            }
            __syncthreads();
        }
    }
};

struct EpiRes {
    static constexpr bool MID = false, AFTER_DRAIN = false, PAIR = false, PERM = true, ALIGN = false;
    const float* src; float* dst; const float* gate;
    __device__ __forceinline__ void operator()(const AccT& acc, const Unit& u, int wr, int wc, int fr, int fq) const {
        const int row0 = u.pm * BM + wr * 64 + fr, col0 = u.pn * BM + wc * 32 + 8 * fq;
        const int b = (u.pm * BM) / SEQ;
        f32x4 gv[2][2];
#pragma unroll
        for (int bj = 0; bj < 2; ++bj)
#pragma unroll
            for (int n = 0; n < 2; ++n) gv[bj][n] = *(const f32x4*)(gate + (size_t)b * 12288 + col0 + bj * HALF + 4 * n);
#pragma unroll
        for (int ai = 0; ai < 2; ++ai)
#pragma unroll
            for (int m = 0; m < 4; ++m) {
                const size_t ro = (size_t)(row0 + ai * HALF + m * 16) * 2048 + col0;
#pragma unroll
                for (int bj = 0; bj < 2; ++bj)
#pragma unroll
                    for (int n = 0; n < 2; ++n) {
                        const f32x4 xv = *(const f32x4*)(src + ro + bj * HALF + 4 * n);
                        *(f32x4*)(dst + ro + bj * HALF + 4 * n) = xv + gv[bj][n] * acc[ai][bj][m][n];
                    }
            }
    }
};

template <bool FINAL> struct EpiResNorm {
    static constexpr bool MID = false, AFTER_DRAIN = true, PAIR = false, PERM = true, ALIGN = false;
    const float* src; float* dst; const float* gate; const float* g; const float* modsh; const float* modsc; bf16_t* H; float* PST; unsigned* cnt; unsigned* bar; unsigned* cnt2;
    __device__ __forceinline__ void operator()(const AccT&, const Unit&, int, int, int, int) const {}
    __device__ __forceinline__ void fused(AccT& acc, const Unit& u, int wr, int wc, int fr, int fq, LAS unsigned char* lds) const {
        const int row0 = u.pm * BM + wr * 64 + fr, col0 = u.pn * BM + wc * 32 + 8 * fq;
        const int b = (u.pm * BM) / SEQ;
        {
            f32x4 gv[2][2];
#pragma unroll
            for (int bj = 0; bj < 2; ++bj)
#pragma unroll
                for (int n = 0; n < 2; ++n) gv[bj][n] = *(const f32x4*)(gate + (size_t)b * 12288 + col0 + bj * HALF + 4 * n);
#pragma unroll
            for (int ai = 0; ai < 2; ++ai)
#pragma unroll
                for (int m = 0; m < 4; ++m) {
                    const int row = row0 + ai * HALF + m * 16; const size_t ro = (size_t)row * 2048 + col0; float s = 0.f;
#pragma unroll
                    for (int bj = 0; bj < 2; ++bj)
#pragma unroll
                        for (int n = 0; n < 2; ++n) {
                            const f32x4 v = __builtin_nontemporal_load((const f32x4*)(src + ro + bj * HALF + 4 * n)) + gv[bj][n] * acc[ai][bj][m][n];
                            acc[ai][bj][m][n] = v; s += sum4(v * v);
                        }
                    s += __shfl_xor(s, 16); s += __shfl_xor(s, 32);
                    if (fq == 0) __hip_atomic_store(PST + (size_t)row * 32 + u.pn * 4 + wc, s, __ATOMIC_RELAXED, __HIP_MEMORY_SCOPE_AGENT);
                }
        }
        asm volatile("s_waitcnt vmcnt(0)" ::: "memory");
        __syncthreads();
        if (threadIdx.x == 0) (void)xb_add(cnt + 64 * u.pm, 1u);
        if (!FINAL) {
#pragma unroll
            for (int ai = 0; ai < 2; ++ai)
#pragma unroll
                for (int m = 0; m < 4; ++m) {
                    const size_t ro = (size_t)(row0 + ai * HALF + m * 16) * 2048 + col0;
#pragma unroll
                    for (int bj = 0; bj < 2; ++bj)
#pragma unroll
                        for (int n = 0; n < 2; ++n) *(f32x4*)(dst + ro + bj * HALF + 4 * n) = acc[ai][bj][m][n];
                }
        }
        if (threadIdx.x == 0) {
            unsigned* cw = cnt + 64 * u.pm;
            XB_SPIN(xb_ld(cw) < 8u, bar);
            __builtin_amdgcn_fence(__ATOMIC_ACQUIRE, "agent");
            asm volatile("s_waitcnt vmcnt(0)" ::: "memory");
        }
        __syncthreads();
        LAS float* R = (LAS float*)lds;
        if (threadIdx.x < 256) {
            const float* ps = PST + (size_t)(u.pm * BM + threadIdx.x) * 32; float s = 0.f;
#pragma unroll
            for (int i = 0; i < 8; ++i) s += sum4(*(const f32x4*)(ps + 4 * i));
            R[threadIdx.x] = rsqrtf(s * (1.0f / 2048.0f) + EPSF);
        }
        __syncthreads();
        const __amdgpu_buffer_rsrc_t rH = __builtin_amdgcn_make_buffer_rsrc((void*)H, (short)0, (int)((size_t)NTOK * 2048 * 2), 0x00020000);
        f32x4 gg[2][2], sv[2][2];
#pragma unroll
        for (int bj = 0; bj < 2; ++bj)
#pragma unroll
            for (int n = 0; n < 2; ++n) {
                const int col = col0 + bj * HALF + 4 * n; gg[bj][n] = *(const f32x4*)(g + col);
                if (!FINAL) { gg[bj][n] *= (*(const f32x4*)(modsc + (size_t)b * 12288 + col) + 1.0f); sv[bj][n] = *(const f32x4*)(modsh + (size_t)b * 12288 + col); }
            }
#pragma unroll
        for (int ai = 0; ai < 2; ++ai)
#pragma unroll
            for (int m = 0; m < 4; ++m) {
                const int rl = wr * 64 + ai * HALF + m * 16 + fr; const float r = R[rl]; const size_t ro = (size_t)(u.pm * BM + rl) * 2048 + col0;
#pragma unroll
                for (int bj = 0; bj < 2; ++bj) {
                    if (FINAL) {
#pragma unroll
                        for (int n = 0; n < 2; ++n) *(f32x4*)(dst + ro + bj * HALF + 4 * n) = acc[ai][bj][m][n] * r * gg[bj][n];
                    } else __builtin_amdgcn_raw_buffer_store_b128(pack8(acc[ai][bj][m][0] * r * gg[bj][0] + sv[bj][0], acc[ai][bj][m][1] * r * gg[bj][1] + sv[bj][1]), rH, (unsigned)((ro + bj * HALF) * 2), 0, 16);
                }
            }
        if (!FINAL && cnt2) {
            asm volatile("s_waitcnt vmcnt(0)" ::: "memory");
            __syncthreads();
            if (threadIdx.x == 0) {
                unsigned* cw = cnt2 + 64 * u.pm;
                (void)xb_add(cw, 1u);
                XB_SPIN(xb_ld(cw) < 8u, bar);
                __builtin_amdgcn_fence(__ATOMIC_ACQUIRE, "agent");
                asm volatile("s_waitcnt vmcnt(0)" ::: "memory");
            }
            __syncthreads();
        }
    }
};

struct EpiSwi {
    static constexpr bool MID = false, AFTER_DRAIN = false, PAIR = false, PERM = true, ALIGN = AL_SW;
    bf16_t* ACT;
    __device__ __forceinline__ void operator()(const AccT& acc, const Unit& u, int wr, int wc, int fr, int fq) const {
        const int row0 = u.pm * BM + wr * 64 + fr, col0 = u.pn * HALF + wc * 32 + 8 * fq;
#pragma unroll
        for (int ai = 0; ai < 2; ++ai)
#pragma unroll
            for (int m = 0; m < 4; ++m)
                *(u32x4*)(ACT + (size_t)(row0 + ai * HALF + m * 16) * FH + col0) =
                    pack8(map4(acc[ai][0][m][0], siluf_) * acc[ai][1][m][0], map4(acc[ai][0][m][1], siluf_) * acc[ai][1][m][1]);
    }
};

__device__ __forceinline__ bf16x8 frag_row(const LAS unsigned char* X, int ldb, int r0, int k0, int fr, int fq) { return *(const LAS bf16x8*)(X + (r0 + fr) * ldb + (k0 + 8 * fq) * 2); }
__device__ __forceinline__ bf16x8 frag_tr(const LAS unsigned char* X, int ldb, int r0, int k0, int fr, int fq) {
    const LAS unsigned char* a = X + (k0 + 8 * fq + (fr >> 2)) * ldb + (r0 + 4 * (fr & 3)) * 2;
    const s16x4 lo = __builtin_amdgcn_ds_read_tr16_b64_v4i16((LAS s16x4*)a), hi = __builtin_amdgcn_ds_read_tr16_b64_v4i16((LAS s16x4*)(a + 4 * ldb));
    return (bf16x8){lo[0], lo[1], lo[2], lo[3], hi[0], hi[1], hi[2], hi[3]};
}
__device__ __forceinline__ f32x4 mma(bf16x8 fn, bf16x8 fm, f32x4 acc) { return __builtin_amdgcn_mfma_f32_16x16x32_bf16(fn, fm, acc, 0, 0, 0); }

constexpr int LD136 = 272;

struct TDesc { const float* src; bf16_t* dst; int N, ldd, mode, k0, n0; };
constexpr int TT0 = 16 * 80, TT1 = TT0 + 8 * 16, TT2 = TT1 + 8 * 16, TT3 = TT2 + 16 * 16, TT4 = TT3 + 16 * 88, TT5 = TT4 + 44 * 16;
__device__ __forceinline__ void tdesc(const Params& p, int t, TDesc& d) {
    int loc;
    if (t < TT0) { d.src = p.w_in; d.dst = p.WinT(); d.N = INW; d.ldd = 2048; d.mode = 0; loc = t; }
    else if (t < TT1) { d.src = p.w_bg; d.dst = p.WaT(); d.N = 2048; d.ldd = 1024; d.mode = 0; loc = t - TT0; }
    else if (t < TT2) { d.src = p.w_bh; d.dst = p.WbT(); d.N = 2048; d.ldd = 1024; d.mode = 0; loc = t - TT1; }
    else if (t < TT3) { d.src = p.w_out; d.dst = p.WoutT(); d.N = 2048; d.ldd = 2048; d.mode = 0; loc = t - TT2; }
    else if (t < TT4) { d.src = p.w_ffn_in; d.dst = p.WfiT(); d.N = 2 * FH; d.ldd = 2048; d.mode = 1; loc = t - TT3; }
    else { d.src = p.w_ffn_out; d.dst = p.WfoT(); d.N = 2048; d.ldd = FH; d.mode = 0; loc = t - TT4; }
    const int ntn = d.N / 128; d.k0 = (loc / ntn) * 128; d.n0 = (loc % ntn) * 128;
}
typedef f32x4 TileRegs[2][2][2];
__device__ __forceinline__ void tile_load(const TDesc& d, TileRegs& r) {
    const int nl = threadIdx.x & 15, kp = threadIdx.x >> 4;
#pragma unroll
    for (int hf = 0; hf < 2; ++hf)
#pragma unroll
        for (int ps = 0; ps < 2; ++ps) {
            const float* s = d.src + (size_t)(d.k0 + 2 * (ps * 32 + kp)) * d.N + d.n0 + hf * 64 + 4 * nl;
            r[hf][ps][0] = __builtin_nontemporal_load((const f32x4*)s); r[hf][ps][1] = __builtin_nontemporal_load((const f32x4*)(s + d.N));
        }
}
__device__ __forceinline__ void tile_to_lds(LAS unsigned* tl, const TileRegs& r) {
    const int nl = threadIdx.x & 15, kp = threadIdx.x >> 4;
#pragma unroll
    for (int hf = 0; hf < 2; ++hf)
#pragma unroll
        for (int ps = 0; ps < 2; ++ps)
#pragma unroll
            for (int j = 0; j < 4; ++j) tl[(hf * 64 + 4 * nl + j) * 65 + ps * 32 + kp] = cvt_pk_bf16(r[hf][ps][0][j], r[hf][ps][1][j]);
}
__device__ __forceinline__ void tile_store(const LAS unsigned* tl, const TDesc& d) {
    const int dq = threadIdx.x & 15;
#pragma unroll
    for (int ps = 0; ps < 4; ++ps) {
        const int n = ps * 32 + (threadIdx.x >> 4); u32x4 w;
        w.x = tl[n * 65 + 4 * dq + 0]; w.y = tl[n * 65 + 4 * dq + 1]; w.z = tl[n * 65 + 4 * dq + 2]; w.w = tl[n * 65 + 4 * dq + 3];
        int gn = d.n0 + n;
        if (d.mode == 1) { const int part = gn >= FH ? 1 : 0, h = gn - part * FH; gn = (h >> 7) * 256 + part * 128 + (h & 127); }
        *(u32x4*)(d.dst + (size_t)gn * d.ldd + d.k0 + 8 * dq) = w;
    }
}
__device__ __forceinline__ void transpose_tiles(const Params& p, LAS unsigned char* lds, int first, int stride, int t_begin, int t_end) {
    LAS unsigned* tl0 = (LAS unsigned*)lds; LAS unsigned* tl1 = tl0 + 128 * 65;
    int t = t_begin + first, buf = 0;
    TDesc cur, nxt; TileRegs r, rn;
    if (t < t_end) { tdesc(p, t, cur); tile_load(cur, r); }
    while (t < t_end) {
        const int tn = t + stride; const bool hn = tn < t_end;
        if (hn) { tdesc(p, tn, nxt); tile_load(nxt, rn); }
        LAS unsigned* tl = buf ? tl1 : tl0;
        tile_to_lds(tl, r);
        __syncthreads();
        tile_store(tl, cur);
        if (hn) {
            cur = nxt;
#pragma unroll
            for (int a = 0; a < 2; ++a)
#pragma unroll
                for (int b = 0; b < 2; ++b) { r[a][b][0] = rn[a][b][0]; r[a][b][1] = rn[a][b][1]; }
        }
        t = tn; buf ^= 1;
    }
    __syncthreads();
}

__device__ void phase0(const Params& p, LAS unsigned char* lds) {
    const int tid = threadIdx.x;
    LAS float* cact = (LAS float*)lds;
    {
        float cv[16];
#pragma unroll
        for (int i = 0; i < 16; ++i) cv[i] = p.c[tid + 512 * i];
#pragma unroll
        for (int i = 0; i < 16; ++i) cact[tid + 512 * i] = siluf_(cv[i]);
    }
    __syncthreads();
    for (int task = blockIdx.x * 512 + tid; task < 3072 * KSPLIT; task += gridDim.x * 512) {
        const int cg4 = task % 3072, ks = task / 3072;
        const float* w = p.w_ada + (size_t)(ks * 64) * 12288 + cg4 * 4;
        f32x4 a0 = {0.f, 0.f, 0.f, 0.f}, a1 = a0, a2 = a0, a3 = a0;
#pragma unroll 16
        for (int k = 0; k < 64; ++k) {
            const f32x4 wv = __builtin_nontemporal_load((const f32x4*)(w + (size_t)k * 12288)); const int kk = ks * 64 + k;
            a0 += wv * cact[kk]; a1 += wv * cact[2048 + kk]; a2 += wv * cact[4096 + kk]; a3 += wv * cact[6144 + kk];
        }
        const __amdgpu_buffer_rsrc_t rp = __builtin_amdgcn_make_buffer_rsrc((void*)p.PART(), (short)0, (int)((size_t)KSPLIT * 4 * 12288 * 4), 0x00020000);
        const unsigned pp = (unsigned)(((size_t)(ks * 4) * 12288 + cg4 * 4) * 4);
        __builtin_amdgcn_raw_buffer_store_b128(__builtin_bit_cast(u32x4, a0), rp, pp, 0, 16); __builtin_amdgcn_raw_buffer_store_b128(__builtin_bit_cast(u32x4, a1), rp, pp + 12288u * 4u, 0, 16);
        __builtin_amdgcn_raw_buffer_store_b128(__builtin_bit_cast(u32x4, a2), rp, pp + 2u * 12288u * 4u, 0, 16); __builtin_amdgcn_raw_buffer_store_b128(__builtin_bit_cast(u32x4, a3), rp, pp + 3u * 12288u * 4u, 0, 16);
    }
    asm volatile("s_waitcnt vmcnt(0)" ::: "memory");
    __syncthreads();
    if ((int)blockIdx.x * 512 < 3072 * KSPLIT && tid == 0) (void)xb_add(p.BAR() + GEMV_CNT, 1u);
    transpose_tiles(p, lds, (int)blockIdx.x, (int)gridDim.x, 0, TT2);
}

__device__ void phase_norm(const Params& p, LAS unsigned char* lds, int mode) {
    const int tid = threadIdx.x, wid = tid >> 6, lane = tid & 63;
    LAS float* gsc = (LAS float*)lds; LAS float* shf = gsc + 2048;
    if (mode == 0) {
        for (int e = blockIdx.x * 512 + tid; e < NB * 12288; e += gridDim.x * 512) {
            const int b = e / 12288, n = e % 12288; float s = p.b_ada[n];
            float pv[KSPLIT];
#pragma unroll
            for (int ks = 0; ks < KSPLIT; ++ks) pv[ks] = p.PART()[(size_t)(ks * 4 + b) * 12288 + n];
#pragma unroll
            for (int ks = 0; ks < KSPLIT; ++ks) s += pv[ks];
            p.MOD()[e] = s;
        }
    }
    const float* src = (mode == 0) ? p.x : p.out;
    const float* g = (mode == 0) ? p.norm1_g : (mode == 1) ? p.norm2_g : p.final_g;
    for (int rg = blockIdx.x; rg < NTOK / 32; rg += gridDim.x) {
        const int b = rg / (SEQ / 32);
        f32x4 xv[4][8];
#pragma unroll
        for (int rr = 0; rr < 4; ++rr)
#pragma unroll
            for (int i = 0; i < 8; ++i) xv[rr][i] = __builtin_nontemporal_load((const f32x4*)(src + ((size_t)rg * 32 + wid * 4 + rr) * 2048 + i * 256 + lane * 4));
        __syncthreads();
        for (int d = tid; d < DM; d += 512) {
            float sh = 0.f, sc = 0.f;
            if (mode == 0) {
                sh = p.b_ada[d]; sc = p.b_ada[2048 + d];
                float p0[KSPLIT], p1[KSPLIT];
#pragma unroll
                for (int ks = 0; ks < KSPLIT; ++ks) { const float* pp = p.PART() + (size_t)(ks * 4 + b) * 12288; p0[ks] = pp[d]; p1[ks] = pp[2048 + d]; }
#pragma unroll
                for (int ks = 0; ks < KSPLIT; ++ks) { sh += p0[ks]; sc += p1[ks]; }
            } else if (mode == 1) { sh = p.MOD()[(size_t)b * 12288 + 3 * 2048 + d]; sc = p.MOD()[(size_t)b * 12288 + 4 * 2048 + d]; }
            gsc[d] = g[d] * (1.0f + sc); shf[d] = sh;
        }
        __syncthreads();
#pragma unroll
        for (int rr = 0; rr < 4; ++rr) {
            const size_t row = (size_t)rg * 32 + wid * 4 + rr;
            float ss = 0.f;
#pragma unroll
            for (int i = 0; i < 8; ++i) ss += (xv[rr][i][0] * xv[rr][i][0] + xv[rr][i][1] * xv[rr][i][1]) + (xv[rr][i][2] * xv[rr][i][2] + xv[rr][i][3] * xv[rr][i][3]);
#pragma unroll
            for (int o = 1; o < 64; o <<= 1) ss += __shfl_xor(ss, o);
            const float r = rsqrtf(ss * (1.0f / 2048.0f) + EPSF);
#pragma unroll
            for (int i = 0; i < 8; ++i) {
                const int col = i * 256 + lane * 4; const f32x4 gg = *(const LAS f32x4*)(gsc + col), sv = *(const LAS f32x4*)(shf + col);
                const f32x4 h = xv[rr][i] * r * gg + sv;
                if (mode == 2) *(f32x4*)(p.out + row * 2048 + col) = h;
                else { u32x2 w; w.x = cvt_pk_bf16(h[0], h[1]); w.y = cvt_pk_bf16(h[2], h[3]); *(u32x2*)(p.H() + row * 2048 + col) = w; }
            }
        }
    }
}

__device__ void gmlp_unit(const Params& p, LAS unsigned char* lds, int bc, int g) {
    const int tid = threadIdx.x, wid = tid >> 6, lane = tid & 63, fr = lane & 15, fq = lane >> 4;
    LAS unsigned char* Wm = lds; LAS unsigned char* VN = lds + 128 * LD136; LAS float* MR = (LAS float*)(lds + 2 * 128 * LD136);
    const int tok0 = bc * 128;
    const int t0 = (wid >> 2) * 64, d0 = (wid & 3) * 32;
    u32x4 vraw[4]; f32x4 wreg[8]; u32x2 ureg[4][2]; float bsv[4]; f32x4 st[8];
#pragma unroll
    for (int i = 0; i < 4; ++i) { const int idx = tid + 512 * i, s = idx >> 4, c8 = (idx & 15) * 8; vraw[i] = __builtin_nontemporal_load((const u32x4*)(p.UV() + (size_t)(tok0 + s) * 2048 + 1024 + g * 128 + c8)); }
    if (tid < 128) {
#pragma unroll
        for (int i = 0; i < 8; ++i) st[i] = __builtin_nontemporal_load((const f32x4*)(p.STAT() + (size_t)(tok0 + tid) * 32 + 4 * i));
    }
    {
        const float* W = p.gws + (size_t)g * 16384;
#pragma unroll
        for (int i = 0; i < 8; ++i) { const int idx = tid + 512 * i; wreg[i] = *(const f32x4*)(W + (idx >> 5) * 128 + (idx & 31) * 4); }
    }
#pragma unroll
    for (int m = 0; m < 4; ++m) {
        const int t = t0 + m * 16 + fr; bsv[m] = p.gbs[g * 128 + t];
#pragma unroll
        for (int n = 0; n < 2; ++n) ureg[m][n] = __builtin_nontemporal_load((const u32x2*)(p.UV() + (size_t)(tok0 + t) * 2048 + g * 128 + d0 + n * 16 + 4 * fq));
    }
    if (tid < 128) {
        float s1 = 0.f, s2 = 0.f;
#pragma unroll
        for (int i = 0; i < 8; ++i) { s1 += st[i][0] + st[i][2]; s2 += st[i][1] + st[i][3]; }
        const float mu = s1 * (1.0f / 1024.0f), var = s2 * (1.0f / 1024.0f) - mu * mu;
        MR[2 * tid] = mu; MR[2 * tid + 1] = rsqrtf(var + EPSF);
    }
#pragma unroll
    for (int i = 0; i < 8; ++i) {
        const int idx = tid + 512 * i, t = idx >> 5, s4 = (idx & 31) * 4; f32x4 w = wreg[i];
#pragma unroll
        for (int j = 0; j < 4; ++j) w[j] = (s4 + j <= t) ? w[j] : 0.f;
        u32x2 o; o.x = cvt_pk_bf16(w[0], w[1]); o.y = cvt_pk_bf16(w[2], w[3]);
        *(LAS u32x2*)(Wm + t * LD136 + s4 * 2) = o;
    }
    __syncthreads();
#pragma unroll
    for (int i = 0; i < 4; ++i) {
        const int idx = tid + 512 * i, s = idx >> 4, c8 = (idx & 15) * 8, ch = g * 128 + c8;
        const u32x4 raw = vraw[i];
        const float mu = MR[2 * s], rs = MR[2 * s + 1];
        const f32x4 g0 = *(const f32x4*)(p.ln_g + ch), g1 = *(const f32x4*)(p.ln_g + ch + 4), b0 = *(const f32x4*)(p.ln_b + ch), b1 = *(const f32x4*)(p.ln_b + ch + 4);
        u32x4 o;
        o.x = cvt_pk_bf16((bf_lo(raw.x) - mu) * rs * g0[0] + b0[0], (bf_hi(raw.x) - mu) * rs * g0[1] + b0[1]);
        o.y = cvt_pk_bf16((bf_lo(raw.y) - mu) * rs * g0[2] + b0[2], (bf_hi(raw.y) - mu) * rs * g0[3] + b0[3]);
        o.z = cvt_pk_bf16((bf_lo(raw.z) - mu) * rs * g1[0] + b1[0], (bf_hi(raw.z) - mu) * rs * g1[1] + b1[1]);
        o.w = cvt_pk_bf16((bf_lo(raw.w) - mu) * rs * g1[2] + b1[2], (bf_hi(raw.w) - mu) * rs * g1[3] + b1[3]);
        *(LAS u32x4*)(VN + s * LD136 + c8 * 2) = o;
    }
    __syncthreads();
    f32x4 acc[4][2];
#pragma unroll
    for (int m = 0; m < 4; ++m) { acc[m][0] = (f32x4){0.f, 0.f, 0.f, 0.f}; acc[m][1] = acc[m][0]; }
#pragma unroll
    for (int ks = 0; ks < 4; ++ks) {
        bf16x8 fn[2], fm[4];
#pragma unroll
        for (int n = 0; n < 2; ++n) fn[n] = frag_tr(VN, LD136, d0 + n * 16, ks * 32, fr, fq);
#pragma unroll
        for (int m = 0; m < 4; ++m) fm[m] = frag_row(Wm, LD136, t0 + m * 16, ks * 32, fr, fq);
#pragma unroll
        for (int m = 0; m < 4; ++m)
#pragma unroll
            for (int n = 0; n < 2; ++n) acc[m][n] = mma(fn[n], fm[m], acc[m][n]);
    }
#pragma unroll
    for (int m = 0; m < 4; ++m) {
        const int t = t0 + m * 16 + fr; const size_t tok = (size_t)(tok0 + t); const float bs = bsv[m];
#pragma unroll
        for (int n = 0; n < 2; ++n) {
            const int ch = g * 128 + d0 + n * 16 + 4 * fq;
            const u32x2 uu = ureg[m][n]; const f32x4 a = acc[m][n];
            u32x2 w; w.x = cvt_pk_bf16((a[0] + bs) * bf_lo(uu.x), (a[1] + bs) * bf_hi(uu.x)); w.y = cvt_pk_bf16((a[2] + bs) * bf_lo(uu.y), (a[3] + bs) * bf_hi(uu.y));
            *(u32x2*)(p.YA() + tok * 1024 + ch) = w;
        }
    }
    __syncthreads();
}

__device__ void hgrn_a_unit(const Params& p, LAS unsigned char* lds, int bh, int c) {
    const int tid = threadIdx.x, wid = tid >> 6, lane = tid & 63, fr = lane & 15, fq = lane >> 4;
    LAS unsigned char* Is = lds; LAS unsigned char* Ks = lds + 64 * LD136; LAS float* SEG = (LAS float*)(lds + 2 * 64 * LD136);
    const int b = bh >> 3, h = bh & 7, tok0 = b * SEQ + c * 64;
#pragma unroll
    for (int i = 0; i < 2; ++i) {
        const int idx = tid + 512 * i, s = idx >> 4, c8 = (idx & 15) * 8;
        *(LAS u32x4*)(Is + s * LD136 + c8 * 2) = __builtin_nontemporal_load((const u32x4*)(p.QIO() + (size_t)(tok0 + s) * 3072 + 1024 + h * 128 + c8));
    }
    const int k = tid & 127, seg = tid >> 7;
    float v[16], kk[16];
#pragma unroll
    for (int i = 0; i < 16; ++i) { v[i] = __builtin_nontemporal_load(p.LF() + (size_t)(tok0 + seg * 16 + i) * 1024 + h * 128 + k); kk[i] = 1.0f - __expf(v[i]); }
#pragma unroll
    for (int i = 1; i < 16; ++i) v[i] += v[i - 1];
    SEG[seg * 128 + k] = v[15];
    __syncthreads();
    float off = 0.f, tot = 0.f;
#pragma unroll
    for (int s = 0; s < 4; ++s) { const float sv = SEG[s * 128 + k]; tot += sv; if (s < seg) off += sv; }
#pragma unroll
    for (int i = 0; i < 16; ++i) { const float bb = v[i] + off; *(LAS bf16_t*)(Ks + (seg * 16 + i) * LD136 + k * 2) = f2bf(kk[i] * __expf(tot - bb)); }
    if (seg == 0) p.DV()[(size_t)(bh * 32 + c) * 128 + k] = __expf(tot);
    __syncthreads();
    const int v0 = (wid >> 2) * 64, k0 = (wid & 3) * 32;
    f32x4 acc[4][2];
#pragma unroll
    for (int m = 0; m < 4; ++m) { acc[m][0] = (f32x4){0.f, 0.f, 0.f, 0.f}; acc[m][1] = acc[m][0]; }
#pragma unroll
    for (int ks = 0; ks < 2; ++ks) {
        bf16x8 fn[2], fm[4];
#pragma unroll
        for (int n = 0; n < 2; ++n) fn[n] = frag_tr(Ks, LD136, k0 + n * 16, ks * 32, fr, fq);
#pragma unroll
        for (int m = 0; m < 4; ++m) fm[m] = frag_tr(Is, LD136, v0 + m * 16, ks * 32, fr, fq);
#pragma unroll
        for (int m = 0; m < 4; ++m)
#pragma unroll
            for (int n = 0; n < 2; ++n) acc[m][n] = mma(fn[n], fm[m], acc[m][n]);
    }
    bf16_t* ds = p.DS() + (size_t)(bh * 32 + c) * 16384;
#pragma unroll
    for (int m = 0; m < 4; ++m)
#pragma unroll
        for (int n = 0; n < 2; ++n) { u32x2 w; w.x = cvt_pk_bf16(acc[m][n][0], acc[m][n][1]); w.y = cvt_pk_bf16(acc[m][n][2], acc[m][n][3]); *(u32x2*)(ds + (v0 + m * 16 + fr) * 128 + k0 + n * 16 + 4 * fq) = w; }
    __syncthreads();
}

__device__ void hgrn_scan(const Params& p) {
    for (int e = blockIdx.x * 512 + threadIdx.x; e < 32 * 2048; e += gridDim.x * 512) {
        const int bh = e >> 11, q8 = e & 2047, k = (q8 & 15) * 8;
        bf16_t* base = p.DS() + (size_t)bh * 32 * 16384 + q8 * 8; const float* dv = p.DV() + (size_t)bh * 32 * 128 + k;
        float S[8];
#pragma unroll
        for (int j = 0; j < 8; ++j) S[j] = 0.f;
        for (int c0 = 0; c0 < 32; c0 += 8) {
            u32x4 dl[8]; f32x4 d0[8], d1[8];
#pragma unroll
            for (int j = 0; j < 8; ++j) { dl[j] = __builtin_nontemporal_load((const u32x4*)(base + (size_t)(c0 + j) * 16384)); d0[j] = *(const f32x4*)(dv + (c0 + j) * 128); d1[j] = *(const f32x4*)(dv + (c0 + j) * 128 + 4); }
#pragma unroll
            for (int j = 0; j < 8; ++j) {
                u32x4 o; o.x = cvt_pk_bf16(S[0], S[1]); o.y = cvt_pk_bf16(S[2], S[3]); o.z = cvt_pk_bf16(S[4], S[5]); o.w = cvt_pk_bf16(S[6], S[7]);
                *(u32x4*)(base + (size_t)(c0 + j) * 16384) = o;
                S[0] = d0[j][0] * S[0] + bf_lo(dl[j].x); S[1] = d0[j][1] * S[1] + bf_hi(dl[j].x); S[2] = d0[j][2] * S[2] + bf_lo(dl[j].y); S[3] = d0[j][3] * S[3] + bf_hi(dl[j].y);
                S[4] = d1[j][0] * S[4] + bf_lo(dl[j].z); S[5] = d1[j][1] * S[5] + bf_hi(dl[j].z); S[6] = d1[j][2] * S[6] + bf_lo(dl[j].w); S[7] = d1[j][3] * S[7] + bf_hi(dl[j].w);
            }
        }
    }
}

__device__ void hgrn_c_unit(const Params& p, LAS unsigned char* lds, int bh, int c) {
    const int tid = threadIdx.x, wid = tid >> 6, lane = tid & 63, fr = lane & 15, fq = lane >> 4;
    constexpr int T64 = 64 * LD136, LDA = 144;
    LAS unsigned char* Qt = lds; LAS unsigned char* Kt = lds + T64; LAS unsigned char* Qh = lds + 2 * T64; LAS unsigned char* Is = lds + 3 * T64;
    LAS unsigned char* ST = lds + 4 * T64; LAS unsigned char* ATT = ST + 128 * LD136; LAS float* RS = (LAS float*)(ATT + 64 * LDA); LAS float* SEG = RS + 256;
    const int b = bh >> 3, h = bh & 7, tok0 = b * SEQ + c * 64;
#pragma unroll
    for (int i = 0; i < 2; ++i) {
        const int idx = tid + 512 * i, s = idx >> 4, c8 = (idx & 15) * 8;
        *(LAS u32x4*)(Is + s * LD136 + c8 * 2) = __builtin_nontemporal_load((const u32x4*)(p.QIO() + (size_t)(tok0 + s) * 3072 + 1024 + h * 128 + c8));
    }
    {
        const bf16_t* sp = p.DS() + (size_t)(bh * 32 + c) * 16384;
#pragma unroll
        for (int i = 0; i < 4; ++i) {
            const int idx = tid + 512 * i, vv = idx >> 4, k8 = (idx & 15) * 8;
            *(LAS u32x4*)(ST + vv * LD136 + k8 * 2) = __builtin_nontemporal_load((const u32x4*)(sp + vv * 128 + k8));
        }
    }
    u32x2 ogr[2][2]; f32x4 ngr[2];
    {
        const int t0e = (wid >> 2) * 32, v0e = (wid & 3) * 32;
#pragma unroll
        for (int n = 0; n < 2; ++n) {
            const int ch = h * 128 + v0e + n * 16 + 4 * fq; ngr[n] = *(const f32x4*)(p.hg_norm_g + ch);
#pragma unroll
            for (int m = 0; m < 2; ++m) ogr[m][n] = __builtin_nontemporal_load((const u32x2*)(p.QIO() + (size_t)(tok0 + t0e + m * 16 + fr) * 3072 + 2048 + ch));
        }
    }
    const int k = tid & 127, seg = tid >> 7;
    float v[16], kk[16], qq[16];
#pragma unroll
    for (int i = 0; i < 16; ++i) {
        const size_t tok = (size_t)(tok0 + seg * 16 + i);
        v[i] = __builtin_nontemporal_load(p.LF() + tok * 1024 + h * 128 + k); kk[i] = 1.0f - __expf(v[i]); qq[i] = bf2f(__builtin_nontemporal_load(p.QIO() + tok * 3072 + h * 128 + k));
    }
#pragma unroll
    for (int i = 1; i < 16; ++i) v[i] += v[i - 1];
    SEG[seg * 128 + k] = v[15];
    __syncthreads();
    float off = 0.f;
#pragma unroll
    for (int s = 0; s < 4; ++s) { const float sv = SEG[s * 128 + k]; if (s < seg) off += sv; }
    const float mid = SEG[k] + SEG[128 + k];
#pragma unroll
    for (int i = 0; i < 16; ++i) {
        const float bb = v[i] + off; const int ro = (seg * 16 + i) * LD136 + k * 2;
        *(LAS bf16_t*)(Qt + ro) = f2bf(qq[i] * __expf(fminf(bb - mid, 80.f)));
        *(LAS bf16_t*)(Kt + ro) = f2bf(kk[i] * __expf(fminf(mid - bb, 80.f)));
        *(LAS bf16_t*)(Qh + ro) = f2bf(qq[i] * __expf(bb));
    }
    __syncthreads();
    {
        const int t0 = (wid >> 2) * 32, s0 = (wid & 3) * 16;
        f32x4 a2[2]; a2[0] = (f32x4){0.f, 0.f, 0.f, 0.f}; a2[1] = a2[0];
#pragma unroll
        for (int ks = 0; ks < 4; ++ks) {
            const bf16x8 fn = frag_row(Kt, LD136, s0, ks * 32, fr, fq);
#pragma unroll
            for (int m = 0; m < 2; ++m) a2[m] = mma(fn, frag_row(Qt, LD136, t0 + m * 16, ks * 32, fr, fq), a2[m]);
        }
#pragma unroll
        for (int m = 0; m < 2; ++m) {
            const int t = t0 + m * 16 + fr, s = s0 + 4 * fq; f32x4 a = a2[m];
#pragma unroll
            for (int j = 0; j < 4; ++j) a[j] = (s + j <= t) ? a[j] : 0.f;
            u32x2 o; o.x = cvt_pk_bf16(a[0], a[1]); o.y = cvt_pk_bf16(a[2], a[3]);
            *(LAS u32x2*)(ATT + t * LDA + s * 2) = o;
        }
    }
    __syncthreads();
    const int t0 = (wid >> 2) * 32, v0 = (wid & 3) * 32, wc = wid & 3;
    f32x4 acc[2][2];
#pragma unroll
    for (int m = 0; m < 2; ++m) { acc[m][0] = (f32x4){0.f, 0.f, 0.f, 0.f}; acc[m][1] = acc[m][0]; }
#pragma unroll
    for (int ks = 0; ks < 4; ++ks) {
        bf16x8 fn[2], fm[2];
#pragma unroll
        for (int n = 0; n < 2; ++n) fn[n] = frag_row(ST, LD136, v0 + n * 16, ks * 32, fr, fq);
#pragma unroll
        for (int m = 0; m < 2; ++m) fm[m] = frag_row(Qh, LD136, t0 + m * 16, ks * 32, fr, fq);
#pragma unroll
        for (int m = 0; m < 2; ++m)
#pragma unroll
            for (int n = 0; n < 2; ++n) acc[m][n] = mma(fn[n], fm[m], acc[m][n]);
    }
#pragma unroll
    for (int ks = 0; ks < 2; ++ks) {
        bf16x8 fn[2], fm[2];
#pragma unroll
        for (int n = 0; n < 2; ++n) fn[n] = frag_tr(Is, LD136, v0 + n * 16, ks * 32, fr, fq);
#pragma unroll
        for (int m = 0; m < 2; ++m) fm[m] = frag_row(ATT, LDA, t0 + m * 16, ks * 32, fr, fq);
#pragma unroll
        for (int m = 0; m < 2; ++m)
#pragma unroll
            for (int n = 0; n < 2; ++n) acc[m][n] = mma(fn[n], fm[m], acc[m][n]);
    }
#pragma unroll
    for (int m = 0; m < 2; ++m) {
        float ss = 0.f;
#pragma unroll
        for (int n = 0; n < 2; ++n) { const f32x4 a = acc[m][n]; ss += (a[0] * a[0] + a[1] * a[1]) + (a[2] * a[2] + a[3] * a[3]); }
        ss += __shfl_xor(ss, 16); ss += __shfl_xor(ss, 32);
        if (fq == 0) RS[(t0 + m * 16 + fr) * 4 + wc] = ss;
    }
    __syncthreads();
#pragma unroll
    for (int m = 0; m < 2; ++m) {
        const int t = t0 + m * 16 + fr; const f32x4 rs4 = *(const LAS f32x4*)(RS + t * 4);
        const float r = rsqrtf(((rs4[0] + rs4[1]) + (rs4[2] + rs4[3])) * (1.0f / 128.0f) + EPSF); const size_t tok = (size_t)(tok0 + t);
#pragma unroll
        for (int n = 0; n < 2; ++n) {
            const int ch = h * 128 + v0 + n * 16 + 4 * fq;
            const f32x4 ng = ngr[n]; const u32x2 og = ogr[m][n]; const f32x4 a = acc[m][n];
            u32x2 w; w.x = cvt_pk_bf16(a[0] * r * ng[0] * bf_lo(og.x), a[1] * r * ng[1] * bf_hi(og.x)); w.y = cvt_pk_bf16(a[2] * r * ng[2] * bf_lo(og.y), a[3] * r * ng[3] * bf_hi(og.y));
            *(u32x2*)(p.YB() + tok * 1024 + ch) = w;
        }
    }
    __syncthreads();
}


__device__ __forceinline__ void gsync(cg::grid_group& grid) {
    asm volatile("s_waitcnt vmcnt(0) lgkmcnt(0)" ::: "memory");
    grid.sync();
    asm volatile("s_waitcnt vmcnt(0)" ::: "memory");
    __syncthreads();
}

#define PHASE(i) if (lo <= (i) && (i) < hi) { if ((i) > lo) xcd_barrier(xb);
#define PHASE_END }
__global__ void __launch_bounds__(512, 2) fwd_megakernel(Params p, int lo, int hi) {
    extern __shared__ __attribute__((aligned(16))) unsigned char shm[];
    LAS unsigned char* lds = (LAS unsigned char*)shm;
    const int G = (int)gridDim.x, c = (int)blockIdx.x;
    volatile LAS unsigned* xst = (volatile LAS unsigned*)(lds + XST_OFF);
    if (threadIdx.x < 4) xst[threadIdx.x] = 0u;
    __syncthreads();
    const XcdBarrier xb = xcd_barrier_post(p.BAR(), xst);

    PHASE(0) phase0(p, lds); PHASE_END
    if (lo <= 1 && 1 < hi) {
        if (1 > lo) {
            if (threadIdx.x == 0) {
                const unsigned need = (unsigned)min(G, (3072 * KSPLIT + 511) / 512);
                XB_SPIN(xb_ld(p.BAR() + GEMV_CNT) < need, p.BAR());
                __builtin_amdgcn_fence(__ATOMIC_ACQUIRE, "agent");
                asm volatile("s_waitcnt vmcnt(0)" ::: "memory");
            }
            __syncthreads();
        }
        phase_norm(p, lds, 0);
    }
    PHASE(2) {
        StaticOrder S; S.init(NTOK, INW, G, c);
        EpiIn E{p.UV(), p.QIO(), p.GAB(), p.LF(), p.STAT(), p.b_gate, p.hg_lb};
        gemm_phase(lds, Gemm{p.H(), p.WinT(), NTOK, INW, DM, nullptr, nullptr}, S, E);
    } PHASE_END
    constexpr int NFI = TT4 - TT3, NFI_A = NFI / 2;
    PHASE(3) {
        LAS unsigned* tlb = (LAS unsigned*)(lds + 73728);
        int j = 0;
        for (int u = c; u < 512 + 1024; u += G, ++j) {
            const int slot = j * G + c; const bool tv = slot < NFI_A;
            TDesc td; TileRegs tr;
            if (tv) { tdesc(p, TT3 + slot, td); tile_load(td, tr); }
            if (u < 512) gmlp_unit(p, lds, u >> 3, u & 7);
            else hgrn_a_unit(p, lds, (u - 512) >> 5, (u - 512) & 31);
            if (tv) { tile_to_lds(tlb, tr); __syncthreads(); tile_store(tlb, td); }
        }
        transpose_tiles(p, lds, c, G, TT3 + j * G, TT3 + NFI_A);
    } PHASE_END
    PHASE(4) hgrn_scan(p); PHASE_END
    PHASE(5) {
        LAS unsigned* tlb = (LAS unsigned*)(lds + TLB5_OFF);
        constexpr int NS5 = (NFI - NFI_A) + (TT3 - TT2);
        int j = 0;
        for (int u = c; u < 1024; u += G, ++j) {
            const int slot = j * G + c; const bool tv = slot < NS5;
            const int tix = slot < (NFI - NFI_A) ? TT3 + NFI_A + slot : TT2 + (slot - (NFI - NFI_A));
            TDesc td; TileRegs tr;
            if (tv) { tdesc(p, tix, td); tile_load(td, tr); }
            hgrn_c_unit(p, lds, u >> 5, u & 31);
            if (tv) { tile_to_lds(tlb, tr); __syncthreads(); tile_store(tlb, td); }
        }
        for (int slot = j * G + c; slot < NS5; slot += G) {
            const int tix = slot < (NFI - NFI_A) ? TT3 + NFI_A + slot : TT2 + (slot - (NFI - NFI_A));
            transpose_tiles(p, lds, 0, 1, tix, tix + 1);
        }
    } PHASE_END
    PHASE(6) {
        PairOrder S; S.init(NTOK, DM, G, c);
        EpiBrPair E{p.GAB(), p.Y(), (G == (NTOK / BM) * (DM / BM)) ? p.BAR() + 10240 : nullptr, p.BAR()};
        gemm_phase(lds, Gemm{p.YA(), p.WaT(), NTOK, DM, 1024, p.YB(), p.WbT()}, S, E);
    } PHASE_END
    const bool fuse = (G == (NTOK / BM) * (DM / BM));
    if (lo <= 7 && 7 < hi) { if (7 > lo && !fuse) xcd_barrier(xb); {
        StaticOrder S; S.init(NTOK, DM, G, c);
        if (fuse) {
            EpiResNorm<false> E{p.x, p.out, p.MOD() + 2 * 2048, p.norm2_g, p.MOD() + 3 * 2048, p.MOD() + 4 * 2048, p.H(), p.STAT(), p.BAR() + 3584, p.BAR(), p.BAR() + 8192};
            gemm_phase(lds, Gemm{p.Y(), p.WoutT(), NTOK, DM, DM, nullptr, nullptr}, S, E);
        } else {
            EpiRes E{p.x, p.out, p.MOD() + 2 * 2048};
            gemm_phase(lds, Gemm{p.Y(), p.WoutT(), NTOK, DM, DM, nullptr, nullptr}, S, E);
        }
    } PHASE_END
    if (!fuse) { PHASE(8) phase_norm(p, lds, 1); PHASE_END }
    if (lo <= 9 && 9 < hi) { if (9 > lo && !fuse) xcd_barrier(xb); {
        StaticOrder S; S.init(NTOK, 2 * FH, G, c);
        EpiSwi E{p.ACT()};
        gemm_phase(lds, Gemm{p.H(), p.WfiT(), NTOK, 2 * FH, DM, nullptr, nullptr}, S, E);
        {
            const int rounds = (S.nwg + G - 1) / G, busy = S.nwg - (rounds - 1) * G;
            if (busy < G) { if (c >= busy) transpose_tiles(p, lds, c - busy, G - busy, TT4, TT5); }
            else transpose_tiles(p, lds, c, G, TT4, TT5);
        }
    } PHASE_END
    PHASE(10) {
        StaticOrder S; S.init(NTOK, DM, G, c);
        if (fuse) {
            EpiResNorm<true> E{p.out, p.out, p.MOD() + 5 * 2048, p.final_g, nullptr, nullptr, nullptr, p.STAT(), p.BAR() + 5632, p.BAR(), nullptr};
            gemm_phase(lds, Gemm{p.ACT(), p.WfoT(), NTOK, DM, FH, nullptr, nullptr}, S, E);
        } else {
            EpiRes E{p.out, p.out, p.MOD() + 5 * 2048};
            gemm_phase(lds, Gemm{p.ACT(), p.WfoT(), NTOK, DM, FH, nullptr, nullptr}, S, E);
        }
    } PHASE_END
    if (!fuse) { PHASE(11) phase_norm(p, lds, 2); PHASE_END }
}


extern "C" void kernel_launch(void* const* d_in, const int* in_sizes, int n_in, void* d_out, int out_size, void* d_ws, size_t ws_size, hipStream_t stream) {
    constexpr size_t kDynLds = DYN_LDS;
    static int grid_blocks = 0;
    if (!grid_blocks) {
        int dev = 0, cus = 0, per_cu = 0;
        hipGetDevice(&dev);
        hipDeviceGetAttribute(&cus, hipDeviceAttributeMultiprocessorCount, dev);
        hipFuncSetAttribute((const void*)fwd_megakernel, hipFuncAttributeMaxDynamicSharedMemorySize, (int)kDynLds);
        hipOccupancyMaxActiveBlocksPerMultiprocessor(&per_cu, fwd_megakernel, 512, kDynLds);
        if (per_cu < 1) per_cu = 1;
        grid_blocks = cus * per_cu;
        if (grid_blocks > 256) grid_blocks = 256;
    }
    Params p{};
    const float* const* in = (const float* const*)d_in;
    p.x = in[0]; p.c = in[1]; p.w_ada = in[2]; p.b_ada = in[3]; p.norm1_g = in[4]; p.w_in = in[5]; p.b_gate = in[6]; p.ln_g = in[7]; p.ln_b = in[8];
    p.gws = in[9]; p.gbs = in[10]; p.hg_lb = in[11]; p.hg_norm_g = in[12]; p.w_bg = in[13]; p.w_bh = in[14]; p.w_out = in[15]; p.norm2_g = in[16];
    p.w_ffn_in = in[17]; p.w_ffn_out = in[18]; p.final_g = in[19];
    p.out = (float*)d_out;
    p.ws = (char*)d_ws;
    if (ws_size < WS_TOTAL) fprintf(stderr, "workspace too small: %zu < %zu\n", ws_size, (size_t)WS_TOTAL);
    hipMemsetAsync((char*)d_ws + OFF_BAR, 0, (size_t)16384 * 4, stream);
    int lo = 0, hi = 12;
    hipLaunchKernelGGL(fwd_megakernel, dim3(grid_blocks), dim3(512), kDynLds, stream, p, lo, hi);
}
```
